# Optimizing an MI355X kernel written in HIP

```python
import jax, jax.numpy as jnp
from jax import lax
import numpy as np

D_MODEL = 1024
BATCH = 8
SEQ = 2048
DEPTH = 2

HEAD_DIM = 64
N_HEADS = D_MODEL // HEAD_DIM
N_A_LAYERS = max(1, DEPTH // 2)
N_B_LAYERS = DEPTH - N_A_LAYERS
DECAY_LORA = 64
ICLR_LORA = 64
N_SHIFT_MIX = 6
DIL_GROUPS = ((128, 1), (512, 4), (2048, 16))
N_GROUPS = len(DIL_GROUPS)
BAND_BLOCK = 128
ROPE_THETA = 10000.0
NORM_EPS = 1e-6
GN_EPS = 64e-5
NEG_INF = -1e30

kernel_name = "yoco_rwkv7_dilated_hybrid"


def _rms(x, g):
    xf = x.astype(jnp.float32)
    return xf * lax.rsqrt(jnp.mean(xf * xf, axis=-1, keepdims=True) + NORM_EPS) * g.astype(jnp.float32)


def _adaln(c, w, b):
    mod = jax.nn.silu(c.astype(jnp.float32)) @ w + b
    shift, scale, gate = jnp.split(mod, 3, axis=-1)
    return shift[:, None, :], scale[:, None, :], gate[:, None, :]


def _rope_tables(seq):
    pos = jnp.arange(seq, dtype=jnp.float32)
    inv = ROPE_THETA ** (-jnp.arange(0, HEAD_DIM, 2, dtype=jnp.float32) / HEAD_DIM)
    ang = pos[:, None] * inv[None, :]
    return jnp.cos(ang), jnp.sin(ang)


def _rope(x, cos, sin):
    c, s = cos[None, :, None, :], sin[None, :, None, :]
    x1, x2 = x[..., : HEAD_DIM // 2], x[..., HEAD_DIM // 2 :]
    return jnp.concatenate([x1 * c - x2 * s, x2 * c + x1 * s], axis=-1)


def _wkv7_scan(r, w, k, v, a, b):
    B, S, H, N = r.shape
    seq_major = lambda t: jnp.moveaxis(t, 1, 0)

    def step(state, inp):
        r_t, w_t, k_t, v_t, a_t, b_t = inp
        sa = jnp.einsum('bhvk,bhk->bhv', state, a_t)
        state = (state * w_t[:, :, None, :]
                 + sa[..., None] * b_t[:, :, None, :]
                 + v_t[..., None] * k_t[:, :, None, :])
        return state, jnp.einsum('bhvk,bhk->bhv', state, r_t)

    init = jnp.zeros((B, H, N, N), jnp.float32)
    _, ys = lax.scan(step, init, tuple(seq_major(t) for t in (r, w, k, v, a, b)))
    return jnp.moveaxis(ys, 0, 1)


def _rwkv7_time_mix(h, mix_mu, w_in, w0, w1, w2, a0, a1, a2, k_k, k_a, r_k, ln_g, ln_b, w_out):
    B, S, D = h.shape
    hf = h.astype(jnp.float32)
    xx = jnp.pad(hf, ((0, 0), (1, 0), (0, 0)))[:, :-1] - hf
    xs = hf[None] + xx[None] * mix_mu.astype(jnp.float32)[:, None, None, :]
    proj = jnp.einsum('pbsd,dpe->pbse', xs[:4], w_in.reshape(D, 4, D))
    r, k, v, g = proj[0], proj[1], proj[2], proj[3]
    w_log = -jax.nn.softplus(-(w0 + jnp.tanh(xs[4] @ w1) @ w2)) - 0.5
    decay = jnp.exp(-jnp.exp(w_log))
    a = jax.nn.sigmoid(a0 + (xs[5] @ a1) @ a2)
    heads = lambda t: t.reshape(B, S, N_HEADS, HEAD_DIM)
    kk = heads(k * k_k)
    kk = kk / jnp.maximum(jnp.sqrt(jnp.sum(kk * kk, axis=-1, keepdims=True)), 1e-12)
    k = k * (1.0 + (a - 1.0) * k_a)
    r, k, v, decay, a = heads(r), heads(k), heads(v), heads(decay), heads(a)
    y = _wkv7_scan(r, decay, k, v, -kk, kk * a)
    mu = jnp.mean(y, axis=-1, keepdims=True)
    var = jnp.mean(jnp.square(y - mu), axis=-1, keepdims=True)
    y = ((y - mu) * lax.rsqrt(var + GN_EPS)).reshape(B, S, D) * ln_g + ln_b
    bonus = jnp.sum(r * k * r_k, axis=-1, keepdims=True) * v
    y = (y + bonus.reshape(B, S, D)) * jax.nn.silu(g)
    return y @ w_out


def _dilated_band_attention(q, k, v, dil, win_sub):
    B, S, H, Dh = q.shape
    L = S // dil
    nb = -(-L // BAND_BLOCK)
    Lp = nb * BAND_BLOCK

    def by_residue(t):
        return t.reshape(B, L, dil, H, Dh).transpose(0, 2, 3, 1, 4)

    qb = jnp.pad(by_residue(q), ((0, 0), (0, 0), (0, 0), (0, Lp - L), (0, 0)))
    qb = qb.reshape(B, dil, H, nb, BAND_BLOCK, Dh)

    def band(t):
        tp = jnp.pad(by_residue(t), ((0, 0), (0, 0), (0, 0), (BAND_BLOCK, Lp - L), (0, 0)))
        tp = tp.reshape(B, dil, H, nb + 1, BAND_BLOCK, Dh)
        return jnp.concatenate([tp[:, :, :, :-1], tp[:, :, :, 1:]], axis=-2)

    kb, vb = band(k), band(v)
    s = jnp.einsum('bdhnqe,bdhnke->bdhnqk', qb, kb)
    qi = jnp.arange(BAND_BLOCK)[:, None]
    kj = jnp.arange(2 * BAND_BLOCK)[None, :]
    diff = BAND_BLOCK + qi - kj
    key_pos = (jnp.arange(nb)[:, None, None] - 1) * BAND_BLOCK + kj[None]
    valid = (diff >= 0) & (diff <= win_sub) & (key_pos >= 0)
    s = jnp.where(valid, s, NEG_INF)
    m = jnp.max(s, axis=-1)
    p = jnp.exp(s - m[..., None])
    l = jnp.sum(p, axis=-1)
    o = jnp.einsum('bdhnqk,bdhnke->bdhnqe', p, vb) / l[..., None]
    o = o.reshape(B, dil, H, Lp, Dh)[:, :, :, :L].transpose(0, 3, 1, 2, 4).reshape(B, S, H, Dh)
    back = lambda t: t.reshape(B, dil, H, Lp)[..., :L].transpose(0, 3, 1, 2).reshape(B, S, H)
    return o, back(m), back(l)


def _dilated_mixer(h, k_sh, v_sh, w_in, q_norm_g, w_out, cos, sin):
    B, S, D = h.shape
    proj = h.astype(jnp.float32) @ w_in
    q = proj[..., : N_GROUPS * D].reshape(B, S, N_GROUPS * N_HEADS, HEAD_DIM)
    gate = proj[..., N_GROUPS * D :]
    q = _rope(_rms(q, q_norm_g), cos, sin) * (HEAD_DIM ** -0.5)
    q = q.reshape(B, S, N_GROUPS, N_HEADS, HEAD_DIM)
    outs, maxes, denoms = [], [], []
    for gi, (win, dil) in enumerate(DIL_GROUPS):
        o, m, l = _dilated_band_attention(q[:, :, gi], k_sh, v_sh, dil, win // dil)
        outs.append(o)
        maxes.append(m)
        denoms.append(l)
    m_all = jnp.stack(maxes)
    wgt = jnp.exp(m_all - jnp.max(m_all, axis=0, keepdims=True)) * jnp.stack(denoms)
    out = jnp.einsum('gbsh,gbshe->bshe', wgt, jnp.stack(outs)) / jnp.sum(wgt, axis=0)[..., None]
    y = out.reshape(B, S, D) * jax.nn.silu(gate)
    return y @ w_out


def setup_inputs(seed: int = 0) -> dict:
    key = jax.random.key(seed)
    ks = jax.random.split(key, 32)
    D, nA, nB = D_MODEL, N_A_LAYERS, N_B_LAYERS
    f32 = jnp.float32
    nrm = lambda k, shape, s: jax.random.normal(k, shape, f32) * s
    return {
        "x": nrm(ks[0], (BATCH, SEQ, D), 1.0),
        "c": nrm(ks[1], (BATCH, D), 1.0),
        "a_ada_w": nrm(ks[2], (nA, D, 3 * D), 0.5 * D ** -0.5),
        "a_ada_b": nrm(ks[3], (nA, 3 * D), 0.02),
        "a_norm_g": 1.0 + nrm(ks[4], (nA, D), 0.02),
        "a_mix_mu": jax.random.uniform(ks[5], (nA, N_SHIFT_MIX, D), f32),
        "a_w_in": nrm(ks[6], (nA, D, 4 * D), D ** -0.5),
        "a_w0": -6.5 + 5.0 * jax.random.uniform(ks[7], (nA, D), f32),
        "a_w1": nrm(ks[8], (nA, D, DECAY_LORA), D ** -0.5),
        "a_w2": nrm(ks[9], (nA, DECAY_LORA, D), 0.5 * DECAY_LORA ** -0.5),
        "a_a0": nrm(ks[10], (nA, D), 0.1),
        "a_a1": nrm(ks[11], (nA, D, ICLR_LORA), D ** -0.5),
        "a_a2": nrm(ks[12], (nA, ICLR_LORA, D), 0.5 * ICLR_LORA ** -0.5),
        "a_k_k": 0.85 + nrm(ks[13], (nA, D), 0.02),
        "a_k_a": 1.0 + nrm(ks[14], (nA, D), 0.02),
        "a_r_k": nrm(ks[15], (nA, N_HEADS, HEAD_DIM), 0.1),
        "a_ln_g": 1.0 + nrm(ks[16], (nA, D), 0.02),
        "a_ln_b": nrm(ks[17], (nA, D), 0.02),
        "a_w_out": nrm(ks[18], (nA, D, D), D ** -0.5),
        "kv_norm_g": 1.0 + nrm(ks[19], (D,), 0.02),
        "w_kv": nrm(ks[20], (D, 2 * D), D ** -0.5),
        "k_norm_g": 1.0 + nrm(ks[21], (HEAD_DIM,), 0.02),
        "b_ada_w": nrm(ks[22], (nB, D, 3 * D), 0.5 * D ** -0.5),
        "b_ada_b": nrm(ks[23], (nB, 3 * D), 0.02),
        "b_norm_g": 1.0 + nrm(ks[24], (nB, D), 0.02),
        "b_w_in": nrm(ks[25], (nB, D, (N_GROUPS + 1) * D), D ** -0.5),
        "b_q_norm_g": 1.0 + nrm(ks[26], (nB, HEAD_DIM), 0.02),
        "b_w_out": nrm(ks[27], (nB, D, D), D ** -0.5),
    }


def reference(x, c, a_ada_w, a_ada_b, a_norm_g, a_mix_mu, a_w_in, a_w0, a_w1, a_w2, a_a0, a_a1, a_a2,
              a_k_k, a_k_a, a_r_k, a_ln_g, a_ln_b, a_w_out, kv_norm_g, w_kv, k_norm_g,
              b_ada_w, b_ada_b, b_norm_g, b_w_in, b_q_norm_g, b_w_out):
    B, S, D = x.shape
    cos, sin = _rope_tables(S)
    xr = x.astype(jnp.float32)
    k_sh = None
    v_sh = None
    for layer in range(DEPTH):
        if layer < N_A_LAYERS:
            i = layer
            shift, scale, gate = _adaln(c, a_ada_w[i], a_ada_b[i])
            h = _rms(xr, a_norm_g[i]) * (1.0 + scale) + shift
            xr = xr + gate * _rwkv7_time_mix(
                h, a_mix_mu[i], a_w_in[i], a_w0[i], a_w1[i], a_w2[i], a_a0[i], a_a1[i], a_a2[i],
                a_k_k[i], a_k_a[i], a_r_k[i], a_ln_g[i], a_ln_b[i], a_w_out[i])
            if layer == N_A_LAYERS - 1:
                kv = _rms(xr, kv_norm_g) @ w_kv
                k_sh = kv[..., :D].reshape(B, S, N_HEADS, HEAD_DIM)
                v_sh = kv[..., D:].reshape(B, S, N_HEADS, HEAD_DIM)
                k_sh = _rope(_rms(k_sh, k_norm_g), cos, sin)
        else:
            j = layer - N_A_LAYERS
            shift, scale, gate = _adaln(c, b_ada_w[j], b_ada_b[j])
            h = _rms(xr, b_norm_g[j]) * (1.0 + scale) + shift
            xr = xr + gate * _dilated_mixer(h, k_sh, v_sh, b_w_in[j], b_q_norm_g[j], b_w_out[j], cos, sin)
    return xr.astype(x.dtype)
```

```cpp
#include <hip/hip_runtime.h>
#include <hip/hip_cooperative_groups.h>
#include <cstdio>
#include <cstdint>
namespace cg = cooperative_groups;

#ifndef ONE_LAUNCH
#define ONE_LAUNCH 1
#endif

typedef __attribute__((ext_vector_type(8))) short bf16x8;
typedef __attribute__((ext_vector_type(4))) float f32x4;
typedef unsigned short bf16_t;

constexpr int T_TOK = 16384;
constexpr int DM = 1024;
constexpr int SEQ = 2048;
constexpr int NTHREADS = 512;
constexpr int LDS_BYTES = 98304;
constexpr int N_PHASES = 12;

constexpr size_t MiB = 1ull << 20;
constexpr size_t OFF_WT_AIN = 0;
constexpr size_t OFF_WT_LORA1 = OFF_WT_AIN + 8 * MiB;
constexpr size_t OFF_WT_W2 = OFF_WT_LORA1 + 512 * 1024;
constexpr size_t OFF_WT_A2 = OFF_WT_W2 + 128 * 1024;
constexpr size_t OFF_WT_AOUT = OFF_WT_A2 + 128 * 1024;
constexpr size_t OFF_WT_KV = OFF_WT_AOUT + 2 * MiB;
constexpr size_t OFF_WT_BIN = OFF_WT_KV + 4 * MiB;
constexpr size_t OFF_WT_BOUT = OFF_WT_BIN + 8 * MiB;
constexpr size_t OFF_MODA = OFF_WT_BOUT + 2 * MiB;
constexpr size_t OFF_MODB = OFF_MODA + 96 * 1024;
constexpr size_t OFF_ROPE = OFF_MODB + 96 * 1024;
constexpr size_t OFF_SPARE = OFF_ROPE + 512 * 1024;
static_assert(OFF_SPARE + 6 * MiB <= 32 * MiB, "slot0 overflow");
constexpr size_t SLOT = 32 * MiB;

struct Params {
  const float* in[28];
  float* out;
  unsigned char* ws;
};

__device__ __forceinline__ float bf2f(unsigned short b) { return __uint_as_float(((unsigned)b) << 16); }
__device__ __forceinline__ unsigned short f2bf(float f) {
  unsigned u = __float_as_uint(f);
  u += 0x7FFFu + ((u >> 16) & 1u);
  return (unsigned short)(u >> 16);
}
__device__ __forceinline__ unsigned pack2(float a, float b) { return (unsigned)f2bf(a) | ((unsigned)f2bf(b) << 16); }
__device__ __forceinline__ float lo_bf(unsigned u) { return __uint_as_float(u << 16); }
__device__ __forceinline__ float hi_bf(unsigned u) { return __uint_as_float(u & 0xFFFF0000u); }

template <int CTRL>
__device__ __forceinline__ float dpp_f(float v) {
  return __builtin_bit_cast(float, __builtin_amdgcn_update_dpp(0, __builtin_bit_cast(int, v), CTRL, 0xF, 0xF, false));
}
__device__ __forceinline__ float row16_sum(float v) {
  v += dpp_f<0xB1>(v);
  v += dpp_f<0x4E>(v);
  v += dpp_f<0x141>(v);
  v += dpp_f<0x140>(v);
  return v;
}
__device__ __forceinline__ float wave_sum(float v) {
#pragma unroll
  for (int o = 32; o >= 1; o >>= 1) v += __shfl_xor(v, o);
  return v;
}
__device__ __forceinline__ float sigmoidf_(float x) { return 1.0f / (1.0f + __expf(-x)); }

__device__ __forceinline__ void transpose_tile(const float* __restrict__ src, int ld_src, int k0, int n0, bf16_t* __restrict__ dst, int ld_dst,
                               int ndst0, int kdst0, const float* __restrict__ scale, float* sm) {
  const int tid = threadIdx.x;
#pragma unroll
  for (int i = 0; i < 8; i++) {
    int k = (tid >> 6) + i * 8, n = tid & 63;
    float v = src[(size_t)(k0 + k) * ld_src + n0 + n];
    if (scale) v *= scale[k0 + k];
    sm[k * 65 + n] = v;
  }
  __syncthreads();
#pragma unroll
  for (int i = 0; i < 8; i++) {
    int n = (tid >> 6) + i * 8, k = tid & 63;
    dst[(size_t)(ndst0 + n) * ld_dst + kdst0 + k] = f2bf(sm[k * 65 + n]);
  }
  __syncthreads();
}

__device__ __forceinline__ void phase_prep(const Params& p, unsigned char* lds) {
  const int tid = threadIdx.x;
  float* sm = (float*)lds;
  unsigned char* ws = p.ws;
  const int NU = 96 + 128 + 3168;
  for (int u = blockIdx.x; u < NU; u += gridDim.x) {
    if (u < 96) {
      const int layer = u / 48, j0 = (u % 48) * 64;
      const float* c = p.in[1];
      const float* W = layer ? p.in[22] : p.in[2];
      const float* bias = layer ? p.in[23] : p.in[3];
      float* mod = (float*)(ws + (layer ? OFF_MODB : OFF_MODA));
      float* sc = sm;
      float* red = sm + 8192;
      for (int i = tid; i < 8192; i += NTHREADS) { float cv = c[i]; sc[i] = cv / (1.0f + __expf(-cv)); }
      __syncthreads();
      const int cl = tid & 63, ds = tid >> 6;
      float acc[8];
#pragma unroll
      for (int b = 0; b < 8; b++) acc[b] = 0.f;
      for (int d = ds * 128; d < ds * 128 + 128; d++) {
        float w = W[(size_t)d * 3072 + j0 + cl];
#pragma unroll
        for (int b = 0; b < 8; b++) acc[b] += sc[b * 1024 + d] * w;
      }
#pragma unroll
      for (int b = 0; b < 8; b++) red[(ds * 8 + b) * 64 + cl] = acc[b];
      __syncthreads();
      {
        const int b = tid >> 6;
        float s = bias[j0 + cl];
#pragma unroll
        for (int d2 = 0; d2 < 8; d2++) s += red[(d2 * 8 + b) * 64 + cl];
        mod[b * 3072 + j0 + cl] = s;
      }
      __syncthreads();
    } else if (u < 224) {
      const int idx = (u - 96) * 512 + tid;
      const int pos = idx >> 5, i = idx & 31;
      float invf = exp2f(-((float)i * (1.0f / 32.0f)) * 13.287712379549449f);
      float angf = (float)pos * invf;
      double rev = (double)angf * 0.15915494309189535;
      rev -= floor(rev);
      float rv = (float)rev;
      float* cs = (float*)(ws + OFF_ROPE);
      cs[idx] = __builtin_amdgcn_cosf(rv);
      cs[65536 + idx] = __builtin_amdgcn_sinf(rv);
    } else {
      int t = u - 224;
      if (t < 1024) {
        transpose_tile(p.in[6], 4096, (t & 15) * 64, (t >> 4) * 64, (bf16_t*)(ws + OFF_WT_AIN), 1024, (t >> 4) * 64, (t & 15) * 64, nullptr, sm);
      } else if ((t -= 1024) < 64) {
        const int job = t >> 4, kt = t & 15;
        const float* src = (job < 2) ? p.in[8] : p.in[11];
        const float* scale = (job == 1) ? (p.in[5] + 4 * 1024) : (job == 3) ? (p.in[5] + 5 * 1024) : nullptr;
        transpose_tile(src, 64, kt * 64, 0, (bf16_t*)(ws + OFF_WT_LORA1), 2048, (job >> 1) * 64, ((job & 1) ? 1024 : 0) + kt * 64, scale, sm);
      } else if ((t -= 64) < 32) {
        const int job = t >> 4, nt = t & 15;
        transpose_tile(job ? p.in[12] : p.in[9], 1024, 0, nt * 64, (bf16_t*)(ws + (job ? OFF_WT_A2 : OFF_WT_W2)), 64, nt * 64, 0, nullptr, sm);
      } else if ((t -= 32) < 256) {
        transpose_tile(p.in[18], 1024, (t & 15) * 64, (t >> 4) * 64, (bf16_t*)(ws + OFF_WT_AOUT), 1024, (t >> 4) * 64, (t & 15) * 64, nullptr, sm);
      } else if ((t -= 256) < 512) {
        transpose_tile(p.in[20], 2048, (t & 15) * 64, (t >> 4) * 64, (bf16_t*)(ws + OFF_WT_KV), 1024, (t >> 4) * 64, (t & 15) * 64, nullptr, sm);
      } else if ((t -= 512) < 1024) {
        transpose_tile(p.in[25], 4096, (t & 15) * 64, (t >> 4) * 64, (bf16_t*)(ws + OFF_WT_BIN), 1024, (t >> 4) * 64, (t & 15) * 64, nullptr, sm);
      } else {
        t -= 1024;
        transpose_tile(p.in[27], 1024, (t & 15) * 64, (t >> 4) * 64, (bf16_t*)(ws + OFF_WT_BOUT), 1024, (t >> 4) * 64, (t & 15) * 64, nullptr, sm);
      }
    }
  }
}

__device__ __forceinline__ void phase_mix(const Params& p) {
  const int lane = threadIdx.x & 63, wave = threadIdx.x >> 6;
  unsigned char* ws = p.ws;
  const float* x = p.in[0];
  const float* ng = p.in[4];
  const float* mu = p.in[5];
  const float* modA = (const float*)(ws + OFF_MODA);
  bf16_t* H = (bf16_t*)(ws + 1 * SLOT);
  bf16_t* XX = (bf16_t*)(ws + 3 * SLOT);
  bf16_t* XS0 = (bf16_t*)((unsigned char*)p.out);
  bf16_t* XS1 = (bf16_t*)((unsigned char*)p.out + SLOT);
  bf16_t* XS2 = (bf16_t*)(ws + 2 * SLOT);
  bf16_t* XS3 = (bf16_t*)(ws + 7 * SLOT);
  for (int u = blockIdx.x; u < T_TOK / 8; u += gridDim.x) {
    const int t = u * 8 + wave;
    const int b = t >> 11, s = t & 2047;
    const float4* xr = (const float4*)(x + (size_t)t * DM);
    const float4* xp = (const float4*)(x + (size_t)(t - 1) * DM);
    float4 cur[4], prv[4];
    float ss = 0.f, ssp = 0.f;
#pragma unroll
    for (int i = 0; i < 4; i++) {
      cur[i] = xr[i * 64 + lane];
      ss += cur[i].x * cur[i].x + cur[i].y * cur[i].y + cur[i].z * cur[i].z + cur[i].w * cur[i].w;
    }
    if (s > 0) {
#pragma unroll
      for (int i = 0; i < 4; i++) {
        prv[i] = xp[i * 64 + lane];
        ssp += prv[i].x * prv[i].x + prv[i].y * prv[i].y + prv[i].z * prv[i].z + prv[i].w * prv[i].w;
      }
    } else {
#pragma unroll
      for (int i = 0; i < 4; i++) prv[i] = make_float4(0.f, 0.f, 0.f, 0.f);
    }
    ss = wave_sum(ss);
    ssp = wave_sum(ssp);
    const float rinv = rsqrtf(ss * (1.0f / 1024.0f) + 1e-6f);
    const float rinvp = rsqrtf(ssp * (1.0f / 1024.0f) + 1e-6f);
#pragma unroll
    for (int i = 0; i < 4; i++) {
      const int d = i * 256 + lane * 4;
      const float4 g4 = *(const float4*)(ng + d);
      const float4 sh4 = *(const float4*)(modA + b * 3072 + d);
      const float4 sc4 = *(const float4*)(modA + b * 3072 + 1024 + d);
      float hc[4], hx[4];
      const float cv[4] = {cur[i].x, cur[i].y, cur[i].z, cur[i].w};
      const float pv[4] = {prv[i].x, prv[i].y, prv[i].z, prv[i].w};
      const float gg[4] = {g4.x, g4.y, g4.z, g4.w};
      const float sh[4] = {sh4.x, sh4.y, sh4.z, sh4.w};
      const float sc[4] = {sc4.x, sc4.y, sc4.z, sc4.w};
#pragma unroll
      for (int e = 0; e < 4; e++) {
        float h = cv[e] * rinv * gg[e] * (1.0f + sc[e]) + sh[e];
        float hp = (s > 0) ? (pv[e] * rinvp * gg[e] * (1.0f + sc[e]) + sh[e]) : 0.f;
        hc[e] = h;
        hx[e] = hp - h;
      }
      const size_t o = (size_t)t * DM + d;
      *(uint2*)(H + o) = make_uint2(pack2(hc[0], hc[1]), pack2(hc[2], hc[3]));
      *(uint2*)(XX + o) = make_uint2(pack2(hx[0], hx[1]), pack2(hx[2], hx[3]));
#pragma unroll
      for (int q = 0; q < 4; q++) {
        const float4 m4 = *(const float4*)(mu + q * 1024 + d);
        float v0 = hc[0] + hx[0] * m4.x, v1 = hc[1] + hx[1] * m4.y, v2 = hc[2] + hx[2] * m4.z, v3 = hc[3] + hx[3] * m4.w;
        bf16_t* dst = (q == 0) ? XS0 : (q == 1) ? XS1 : (q == 2) ? XS2 : XS3;
        *(uint2*)(dst + o) = make_uint2(pack2(v0, v1), pack2(v2, v3));
      }
    }
  }
}

struct GemmArgs {
  const bf16_t* A0; const bf16_t* A1; int ksplit; int lda;
  const bf16_t* Bt; int ldb; int K;
};

template <class Epi>
__device__ __forceinline__ void gemm_tile(const GemmArgs& g, int m0, int n0, unsigned char* lds, const Epi& epi) {
  const int tid = threadIdx.x, lane = tid & 63, wave = tid >> 6;
  const int wm = wave & 3, wn = wave >> 2;
  const int fr = lane & 15, fq = lane >> 4;
  bf16_t* As = (bf16_t*)lds;
  bf16_t* Bs = (bf16_t*)(lds + 2 * 256 * 80);
  f32x4 acc[4][4];
#pragma unroll
  for (int i = 0; i < 4; i++)
#pragma unroll
    for (int j = 0; j < 4; j++) acc[i][j] = (f32x4){0.f, 0.f, 0.f, 0.f};
  const int ar0 = tid >> 2, ak = (tid & 3) * 8;
  uint4 ra0, ra1, rb;
  const int nk = g.K >> 5;
  auto gload = [&](int kt) {
    const int kg = kt * 32 + ak;
    const bf16_t* Ab = (kg < g.ksplit) ? (g.A0 + kg) : (g.A1 + (kg - g.ksplit));
    ra0 = *(const uint4*)(Ab + (size_t)(m0 + ar0) * g.lda);
    ra1 = *(const uint4*)(Ab + (size_t)(m0 + ar0 + 128) * g.lda);
    rb = *(const uint4*)(g.Bt + (size_t)(n0 + ar0) * g.ldb + kg);
  };
  auto swrite = [&](int st) {
    *(uint4*)(As + (st * 256 + ar0) * 40 + ak) = ra0;
    *(uint4*)(As + (st * 256 + ar0 + 128) * 40 + ak) = ra1;
    *(uint4*)(Bs + (st * 128 + ar0) * 40 + ak) = rb;
  };
  gload(0);
  swrite(0);
  __syncthreads();
  for (int kt = 0; kt < nk; kt++) {
    const int st = kt & 1;
    if (kt + 1 < nk) gload(kt + 1);
    const bf16_t* Asr = As + (st * 256 + wm * 64 + fr) * 40 + fq * 8;
    const bf16_t* Bsr = Bs + (st * 128 + wn * 64 + fr) * 40 + fq * 8;
    bf16x8 a[4], b[4];
#pragma unroll
    for (int i = 0; i < 4; i++) a[i] = *(const bf16x8*)(Asr + i * 16 * 40);
#pragma unroll
    for (int i = 0; i < 4; i++) b[i] = *(const bf16x8*)(Bsr + i * 16 * 40);
#pragma unroll
    for (int i = 0; i < 4; i++)
#pragma unroll
      for (int j = 0; j < 4; j++) acc[i][j] = __builtin_amdgcn_mfma_f32_16x16x32_bf16(a[i], b[j], acc[i][j], 0, 0, 0);
    if (kt + 1 < nk) swrite(st ^ 1);
    __syncthreads();
  }
  epi(acc, m0 + wm * 64, n0 + wn * 64, fr, fq);
}

struct EpiStoreBf16 {
  bf16_t* dst; int ldd; int coff;
  __device__ __forceinline__ void operator()(f32x4 (&acc)[4][4], int m0w, int n0w, int fr, int fq) const {
#pragma unroll
    for (int mi = 0; mi < 4; mi++)
#pragma unroll
      for (int j = 0; j < 4; j++) {
        const size_t row = m0w + mi * 16 + fq * 4 + j;
#pragma unroll
        for (int ni = 0; ni < 4; ni++) dst[row * ldd + coff + n0w + ni * 16 + fr] = f2bf(acc[mi][ni][j]);
      }
  }
};
struct EpiLora1 {
  bf16_t* dst;
  __device__ __forceinline__ void operator()(f32x4 (&acc)[4][4], int m0w, int n0w, int fr, int fq) const {
#pragma unroll
    for (int mi = 0; mi < 4; mi++)
#pragma unroll
      for (int j = 0; j < 4; j++) {
        const size_t row = m0w + mi * 16 + fq * 4 + j;
#pragma unroll
        for (int ni = 0; ni < 4; ni++) {
          float v = acc[mi][ni][j];
          if (n0w < 64) v = tanhf(v);
          dst[row * 128 + n0w + ni * 16 + fr] = f2bf(v);
        }
      }
  }
};
struct EpiLora2W {
  float* dst; const float* w0;
  __device__ __forceinline__ void operator()(f32x4 (&acc)[4][4], int m0w, int n0w, int fr, int fq) const {
#pragma unroll
    for (int ni = 0; ni < 4; ni++) {
      const int col = n0w + ni * 16 + fr;
      const float bias = w0[col];
#pragma unroll
      for (int mi = 0; mi < 4; mi++)
#pragma unroll
        for (int j = 0; j < 4; j++) {
          const size_t row = m0w + mi * 16 + fq * 4 + j;
          const float sg = sigmoidf_(acc[mi][ni][j] + bias);
          dst[row * DM + col] = __expf(-0.6065306597126334f * sg);
        }
    }
  }
};
struct EpiLora2A {
  bf16_t* dst; const float* a0;
  __device__ __forceinline__ void operator()(f32x4 (&acc)[4][4], int m0w, int n0w, int fr, int fq) const {
#pragma unroll
    for (int ni = 0; ni < 4; ni++) {
      const int col = n0w + ni * 16 + fr;
      const float bias = a0[col];
#pragma unroll
      for (int mi = 0; mi < 4; mi++)
#pragma unroll
        for (int j = 0; j < 4; j++) {
          const size_t row = m0w + mi * 16 + fq * 4 + j;
          dst[row * DM + col] = f2bf(sigmoidf_(acc[mi][ni][j] + bias));
        }
    }
  }
};
struct EpiGPost {
  const float* Y; const bf16_t* RKV; const bf16_t* AICL;
  const float* k_a; const float* r_k; const float* ln_g; const float* ln_b;
  bf16_t* dst;
  __device__ __forceinline__ void operator()(f32x4 (&acc)[4][4], int m0w, int n0w, int fr, int fq) const {
    float ka[4], rk[4], lg[4], lb[4];
#pragma unroll
    for (int ni = 0; ni < 4; ni++) {
      const int col = n0w + ni * 16 + fr;
      ka[ni] = k_a[col]; rk[ni] = r_k[col]; lg[ni] = ln_g[col]; lb[ni] = ln_b[col];
    }
#pragma unroll
    for (int mi = 0; mi < 4; mi++)
#pragma unroll
      for (int j = 0; j < 4; j++) {
        const size_t row = m0w + mi * 16 + fq * 4 + j;
        float yv[4], vv[4];
        float sy = 0.f, sb = 0.f;
#pragma unroll
        for (int ni = 0; ni < 4; ni++) {
          const int col = n0w + ni * 16 + fr;
          yv[ni] = Y[row * DM + col];
          sy += yv[ni];
          const float r = bf2f(RKV[row * 3072 + col]);
          const float k = bf2f(RKV[row * 3072 + 1024 + col]);
          vv[ni] = bf2f(RKV[row * 3072 + 2048 + col]);
          const float a = bf2f(AICL[row * DM + col]);
          const float km = k * (1.0f + (a - 1.0f) * ka[ni]);
          sb += r * km * rk[ni];
        }
        sy = row16_sum(sy);
        sb = row16_sum(sb);
        const float mean = sy * (1.0f / 64.0f);
        float sv = 0.f;
#pragma unroll
        for (int ni = 0; ni < 4; ni++) { const float d = yv[ni] - mean; sv += d * d; }
        sv = row16_sum(sv);
        const float rstd = rsqrtf(sv * (1.0f / 64.0f) + 64e-5f);
#pragma unroll
        for (int ni = 0; ni < 4; ni++) {
          const int col = n0w + ni * 16 + fr;
          const float yn = (yv[ni] - mean) * rstd * lg[ni] + lb[ni];
          const float gp = acc[mi][ni][j];
          const float o = (yn + sb * vv[ni]) * (gp * sigmoidf_(gp));
          dst[row * DM + col] = f2bf(o);
        }
      }
  }
};
struct EpiResidual {
  const float* res; const float* gate; float* dst;
  __device__ __forceinline__ void operator()(f32x4 (&acc)[4][4], int m0w, int n0w, int fr, int fq) const {
    const int b = m0w >> 11;
#pragma unroll
    for (int ni = 0; ni < 4; ni++) {
      const int col = n0w + ni * 16 + fr;
      const float gt = gate[b * 3072 + col];
#pragma unroll
      for (int mi = 0; mi < 4; mi++)
#pragma unroll
        for (int j = 0; j < 4; j++) {
          const size_t row = m0w + mi * 16 + fq * 4 + j;
          dst[row * DM + col] = res[row * DM + col] + gt * acc[mi][ni][j];
        }
    }
  }
};
__device__ __forceinline__ void headnorm_rope_store(f32x4 (&acc)[4][4], int m0w, int fr, int fq, bf16_t* dst, int dcol,
                                                    const float* gain, float scale, const float* cs, const float* sn) {
  float gn[4];
#pragma unroll
  for (int ni = 0; ni < 4; ni++) gn[ni] = gain[ni * 16 + fr];
#pragma unroll
  for (int mi = 0; mi < 4; mi++)
#pragma unroll
    for (int j = 0; j < 4; j++) {
      const size_t row = m0w + mi * 16 + fq * 4 + j;
      const int pos = (int)(row & 2047);
      float ss = 0.f;
#pragma unroll
      for (int ni = 0; ni < 4; ni++) ss += acc[mi][ni][j] * acc[mi][ni][j];
      ss = row16_sum(ss);
      const float rinv = rsqrtf(ss * (1.0f / 64.0f) + 1e-6f) * scale;
      const float v0 = acc[mi][0][j] * rinv * gn[0], v1 = acc[mi][1][j] * rinv * gn[1];
      const float v2 = acc[mi][2][j] * rinv * gn[2], v3 = acc[mi][3][j] * rinv * gn[3];
      const float c0 = cs[pos * 32 + fr], s0 = sn[pos * 32 + fr];
      const float c1 = cs[pos * 32 + 16 + fr], s1 = sn[pos * 32 + 16 + fr];
      bf16_t* d = dst + row * DM + dcol + fr;
      d[0] = f2bf(v0 * c0 - v2 * s0);
      d[16] = f2bf(v1 * c1 - v3 * s1);
      d[32] = f2bf(v2 * c0 + v0 * s0);
      d[48] = f2bf(v3 * c1 + v1 * s1);
    }
}
struct EpiKV {
  bf16_t* KSH; bf16_t* VSH; const float* kg; const float* cs; const float* sn;
  __device__ __forceinline__ void operator()(f32x4 (&acc)[4][4], int m0w, int n0w, int fr, int fq) const {
    if (n0w < 1024) {
      headnorm_rope_store(acc, m0w, fr, fq, KSH, n0w, kg, 1.0f, cs, sn);
    } else {
      EpiStoreBf16 e{VSH, DM, -1024};
      e(acc, m0w, n0w, fr, fq);
    }
  }
};
struct EpiQ {
  bf16_t* Q0; bf16_t* Q1; bf16_t* Q2; const float* qg; const float* cs; const float* sn;
  __device__ __forceinline__ void operator()(f32x4 (&acc)[4][4], int m0w, int n0w, int fr, int fq) const {
    const int g = n0w >> 10;
    bf16_t* Q = (g == 0) ? Q0 : (g == 1) ? Q1 : Q2;
    headnorm_rope_store(acc, m0w, fr, fq, Q, n0w & 1023, qg, 0.125f, cs, sn);
  }
};
struct EpiMerge {
  const bf16_t* O0; const bf16_t* O1; const bf16_t* O2; const float2* ML; bf16_t* dst;
  __device__ __forceinline__ void operator()(f32x4 (&acc)[4][4], int m0w, int n0w, int fr, int fq) const {
    const int h = n0w >> 6;
#pragma unroll
    for (int mi = 0; mi < 4; mi++)
#pragma unroll
      for (int j = 0; j < 4; j++) {
        const size_t row = m0w + mi * 16 + fq * 4 + j;
        const float2 a0 = ML[(0 * (size_t)T_TOK + row) * 16 + h];
        const float2 a1 = ML[(1 * (size_t)T_TOK + row) * 16 + h];
        const float2 a2 = ML[(2 * (size_t)T_TOK + row) * 16 + h];
        const float M = fmaxf(a0.x, fmaxf(a1.x, a2.x));
        const float w0 = __expf(a0.x - M) * a0.y, w1 = __expf(a1.x - M) * a1.y, w2 = __expf(a2.x - M) * a2.y;
        const float inv = 1.0f / (w0 + w1 + w2);
#pragma unroll
        for (int ni = 0; ni < 4; ni++) {
          const size_t o = row * DM + n0w + ni * 16 + fr;
          const float ov = (w0 * bf2f(O0[o]) + w1 * bf2f(O1[o]) + w2 * bf2f(O2[o])) * inv;
          const float gp = acc[mi][ni][j];
          dst[o] = f2bf(ov * gp * sigmoidf_(gp));
        }
      }
  }
};

constexpr int SC_STEP = 360;
constexpr int SC_CH = 16;
__device__ __forceinline__ void phase_scan(const Params& p, unsigned char* lds) {
  float* inbuf = (float*)lds;
  float* ybuf = (float*)(lds + 2 * SC_CH * SC_STEP * 4);
  const int tid = threadIdx.x, lane = tid & 63, wave = tid >> 6;
  unsigned char* ws = p.ws;
  const bf16_t* RKV = (const bf16_t*)(ws + 4 * SLOT);
  const float* WDEC = (const float*)p.out;
  const bf16_t* AICL = (const bf16_t*)(ws + 1 * SLOT);
  float* Y = (float*)(ws + 2 * SLOT);
  const float* k_k = p.in[13];
  const float* k_a = p.in[14];
  constexpr int NCH = SEQ / SC_CH;
  for (int tile = blockIdx.x; tile < 256; tile += gridDim.x) {
    const int b = tile >> 5, h = (tile >> 1) & 15, half = tile & 1;
    const size_t tok0 = (size_t)b * SEQ;
    if (wave >= 4) {
      const int lw = wave - 4, ss = lane >> 4, eg = lane & 15, e0 = eg * 4;
      const int stp = lw * 4 + ss;
      const float4 kk4 = *(const float4*)(k_k + h * 64 + e0);
      const float4 ka4 = *(const float4*)(k_a + h * 64 + e0);
      uint2 cr, ck, ca, cv; float4 cw;
      uint2 nr, nk_, na, nv; float4 nw;
      cv = make_uint2(0, 0); nv = make_uint2(0, 0);
      {
        const size_t tok = tok0 + stp;
        cr = *(const uint2*)(RKV + tok * 3072 + h * 64 + e0);
        ck = *(const uint2*)(RKV + tok * 3072 + 1024 + h * 64 + e0);
        ca = *(const uint2*)(AICL + tok * DM + h * 64 + e0);
        cw = *(const float4*)(WDEC + tok * DM + h * 64 + e0);
        if (eg < 8) cv = *(const uint2*)(RKV + tok * 3072 + 2048 + h * 64 + half * 32 + eg * 4);
      }
      for (int c = -1; c < NCH; c++) {
        if (c + 2 < NCH) {
          const size_t tok = tok0 + (size_t)(c + 2) * SC_CH + stp;
          nr = *(const uint2*)(RKV + tok * 3072 + h * 64 + e0);
          nk_ = *(const uint2*)(RKV + tok * 3072 + 1024 + h * 64 + e0);
          na = *(const uint2*)(AICL + tok * DM + h * 64 + e0);
          nw = *(const float4*)(WDEC + tok * DM + h * 64 + e0);
          if (eg < 8) nv = *(const uint2*)(RKV + tok * 3072 + 2048 + h * 64 + half * 32 + eg * 4);
        }
        if (c + 1 < NCH) {
          const float r[4] = {lo_bf(cr.x), hi_bf(cr.x), lo_bf(cr.y), hi_bf(cr.y)};
          const float k[4] = {lo_bf(ck.x), hi_bf(ck.x), lo_bf(ck.y), hi_bf(ck.y)};
          const float a[4] = {lo_bf(ca.x), hi_bf(ca.x), lo_bf(ca.y), hi_bf(ca.y)};
          const float w[4] = {cw.x, cw.y, cw.z, cw.w};
          const float kkc[4] = {kk4.x, kk4.y, kk4.z, kk4.w};
          const float kac[4] = {ka4.x, ka4.y, ka4.z, ka4.w};
          float kkr[4], km[4];
          float n2 = 0.f;
#pragma unroll
          for (int i = 0; i < 4; i++) { kkr[i] = k[i] * kkc[i]; n2 += kkr[i] * kkr[i]; km[i] = k[i] * (1.0f + (a[i] - 1.0f) * kac[i]); }
          n2 = row16_sum(n2);
          const float inv = 1.0f / fmaxf(sqrtf(n2), 1e-12f);
          float an[4], bv[4], wr[4];
          float br = 0.f, kr = 0.f;
#pragma unroll
          for (int i = 0; i < 4; i++) {
            const float kk = kkr[i] * inv;
            an[i] = -kk; bv[i] = kk * a[i]; wr[i] = w[i] * r[i];
            br += bv[i] * r[i]; kr += km[i] * r[i];
          }
          br = row16_sum(br);
          kr = row16_sum(kr);
          float* base = inbuf + (((c + 1) & 1) * SC_CH + stp) * SC_STEP;
          *(float4*)(base + e0) = cw;
          *(float4*)(base + 64 + e0) = make_float4(bv[0], bv[1], bv[2], bv[3]);
          *(float4*)(base + 128 + e0) = make_float4(km[0], km[1], km[2], km[3]);
          *(float4*)(base + 192 + e0) = make_float4(an[0], an[1], an[2], an[3]);
          *(float4*)(base + 256 + e0) = make_float4(wr[0], wr[1], wr[2], wr[3]);
          if (eg == 0) *(float2*)(base + 320) = make_float2(br, kr);
          if (eg < 8) *(float4*)(base + 324 + eg * 4) = make_float4(lo_bf(cv.x), hi_bf(cv.x), lo_bf(cv.y), hi_bf(cv.y));
        }
        if (c >= 1) {
          const int idx = (tid - 256) * 2;
          const int st = idx >> 5, rr = idx & 31;
          const float2 yv = *(const float2*)(ybuf + (((c + 1) & 1) * SC_CH + st) * 32 + rr);
          *(float2*)(Y + (tok0 + (size_t)(c - 1) * SC_CH + st) * DM + h * 64 + half * 32 + rr) = yv;
        }
        cr = nr; ck = nk_; ca = na; cv = nv; cw = nw;
        __syncthreads();
      }
      {
        const int idx = (tid - 256) * 2;
        const int st = idx >> 5, rr = idx & 31;
        const float2 yv = *(const float2*)(ybuf + (((NCH - 1) & 1) * SC_CH + st) * 32 + rr);
        *(float2*)(Y + (tok0 + (size_t)(NCH - 1) * SC_CH + st) * DM + h * 64 + half * 32 + rr) = yv;
      }
    } else {
      const int sub = lane & 15, rp = lane >> 4;
      const int rl = wave * 8 + rp * 2;
      float2 st[4];
#pragma unroll
      for (int e = 0; e < 4; e++) st[e] = make_float2(0.f, 0.f);
      for (int c = -1; c < NCH; c++) {
        if (c >= 0) {
          const float* cb = inbuf + ((c & 1) * SC_CH) * SC_STEP;
          float* yb = ybuf + ((c & 1) * SC_CH) * 32;
#pragma unroll 4
          for (int s = 0; s < SC_CH; s++) {
            const float* base = cb + s * SC_STEP;
            const float4 w4 = *(const float4*)(base + sub * 4);
            const float4 b4 = *(const float4*)(base + 64 + sub * 4);
            const float4 k4 = *(const float4*)(base + 128 + sub * 4);
            const float4 a4 = *(const float4*)(base + 192 + sub * 4);
            const float4 q4 = *(const float4*)(base + 256 + sub * 4);
            const float2 bk = *(const float2*)(base + 320);
            const float2 v2 = *(const float2*)(base + 324 + rl);
            const float wv[4] = {w4.x, w4.y, w4.z, w4.w};
            const float bv[4] = {b4.x, b4.y, b4.z, b4.w};
            const float kv[4] = {k4.x, k4.y, k4.z, k4.w};
            const float av[4] = {a4.x, a4.y, a4.z, a4.w};
            const float qv[4] = {q4.x, q4.y, q4.z, q4.w};
            float sa0 = 0.f, sa1 = 0.f, sy0 = 0.f, sy1 = 0.f;
#pragma unroll
            for (int e = 0; e < 4; e++) {
              sa0 += st[e].x * av[e]; sa1 += st[e].y * av[e];
              sy0 += st[e].x * qv[e]; sy1 += st[e].y * qv[e];
            }
            sa0 = row16_sum(sa0); sa1 = row16_sum(sa1);
            sy0 = row16_sum(sy0); sy1 = row16_sum(sy1);
            const float y0 = sy0 + sa0 * bk.x + v2.x * bk.y;
            const float y1 = sy1 + sa1 * bk.x + v2.y * bk.y;
#pragma unroll
            for (int e = 0; e < 4; e++) {
              st[e].x = st[e].x * wv[e] + sa0 * bv[e] + v2.x * kv[e];
              st[e].y = st[e].y * wv[e] + sa1 * bv[e] + v2.y * kv[e];
            }
            if (sub == 0) *(float2*)(yb + s * 32 + rl) = make_float2(y0, y1);
          }
        }
        __syncthreads();
      }
    }
    __syncthreads();
  }
}

__device__ __forceinline__ void phase_norm2(const Params& p) {
  const int lane = threadIdx.x & 63, wave = threadIdx.x >> 6;
  unsigned char* ws = p.ws;
  const float* X1 = (const float*)(ws + 2 * SLOT);
  const float* kvg = p.in[19];
  const float* bg = p.in[24];
  const float* modB = (const float*)(ws + OFF_MODB);
  bf16_t* A1 = (bf16_t*)(ws + 4 * SLOT);
  bf16_t* A2 = (bf16_t*)(ws + 5 * SLOT);
  for (int u = blockIdx.x; u < T_TOK / 8; u += gridDim.x) {
    const int t = u * 8 + wave;
    const int b = t >> 11;
    const float4* xr = (const float4*)(X1 + (size_t)t * DM);
    float4 cur[4];
    float ss = 0.f;
#pragma unroll
    for (int i = 0; i < 4; i++) {
      cur[i] = xr[i * 64 + lane];
      ss += cur[i].x * cur[i].x + cur[i].y * cur[i].y + cur[i].z * cur[i].z + cur[i].w * cur[i].w;
    }
    ss = wave_sum(ss);
    const float rinv = rsqrtf(ss * (1.0f / 1024.0f) + 1e-6f);
#pragma unroll
    for (int i = 0; i < 4; i++) {
      const int d = i * 256 + lane * 4;
      const float4 g1 = *(const float4*)(kvg + d);
      const float4 g2 = *(const float4*)(bg + d);
      const float4 sh = *(const float4*)(modB + b * 3072 + d);
      const float4 sc = *(const float4*)(modB + b * 3072 + 1024 + d);
      const float n0 = cur[i].x * rinv, n1 = cur[i].y * rinv, n2 = cur[i].z * rinv, n3 = cur[i].w * rinv;
      const size_t o = (size_t)t * DM + d;
      *(uint2*)(A1 + o) = make_uint2(pack2(n0 * g1.x, n1 * g1.y), pack2(n2 * g1.z, n3 * g1.w));
      *(uint2*)(A2 + o) = make_uint2(pack2(n0 * g2.x * (1.f + sc.x) + sh.x, n1 * g2.y * (1.f + sc.y) + sh.y),
                                     pack2(n2 * g2.z * (1.f + sc.z) + sh.z, n3 * g2.w * (1.f + sc.w) + sh.w));
    }
  }
}

__device__ __forceinline__ void phase_attn(const Params& p, unsigned char* lds) {
  bf16_t* Ks = (bf16_t*)lds;
  bf16_t* Vt = (bf16_t*)(lds + 256 * 144);
  const int tid = threadIdx.x, lane = tid & 63, wave = tid >> 6;
  const int c16 = lane & 15, quad = lane >> 4;
  unsigned char* ws = p.ws;
  const bf16_t* KSH = (const bf16_t*)(ws + 6 * SLOT);
  const bf16_t* VSH = (const bf16_t*)(ws + 7 * SLOT);
  bf16_t* Q0 = (bf16_t*)p.out;
  bf16_t* Q1 = (bf16_t*)((unsigned char*)p.out + SLOT);
  bf16_t* Q2 = (bf16_t*)(ws + 1 * SLOT);
  float2* ML = (float2*)(ws + OFF_SPARE);
  for (int tile = blockIdx.x; tile < 6144; tile += gridDim.x) {
    const int g = tile >> 11, rem = tile & 2047;
    const int b = rem >> 8, h = (rem >> 4) & 15, jj = rem & 15;
    const int dsh = g * 2, dil = 1 << dsh;
    const int r = jj & (dil - 1), n = jj >> dsh;
    bf16_t* Qg = (g == 0) ? Q0 : (g == 1) ? Q1 : Q2;
    const size_t tokb = (size_t)b * SEQ;
#pragma unroll
    for (int i = 0; i < 4; i++) {
      const int c = tid + i * 512;
      const int kl = c >> 3, ec = (c & 7) * 8;
      const int lp = (n - 1) * 128 + kl;
      uint4 val = make_uint4(0, 0, 0, 0);
      if (lp >= 0) val = *(const uint4*)(KSH + (tokb + (size_t)(lp * dil + r)) * DM + h * 64 + ec);
      *(uint4*)(Ks + kl * 72 + ec) = val;
    }
#pragma unroll
    for (int i = 0; i < 4; i++) {
      const int c = tid + i * 512;
      const int ec = (c >> 8) * 8, kl = c & 255;
      const int lp = (n - 1) * 128 + kl;
      uint4 val = make_uint4(0, 0, 0, 0);
      if (lp >= 0) val = *(const uint4*)(VSH + (tokb + (size_t)(lp * dil + r)) * DM + h * 64 + ec);
      bf16_t* vd = Vt + ec * 264 + kl;
      vd[0 * 264] = (bf16_t)(val.x & 0xFFFF); vd[1 * 264] = (bf16_t)(val.x >> 16);
      vd[2 * 264] = (bf16_t)(val.y & 0xFFFF); vd[3 * 264] = (bf16_t)(val.y >> 16);
      vd[4 * 264] = (bf16_t)(val.z & 0xFFFF); vd[5 * 264] = (bf16_t)(val.z >> 16);
      vd[6 * 264] = (bf16_t)(val.w & 0xFFFF); vd[7 * 264] = (bf16_t)(val.w >> 16);
    }
    __syncthreads();
    const int lq = n * 128 + wave * 16 + c16;
    const int posq = lq * dil + r;
    const size_t qoff = (tokb + posq) * DM + h * 64;
    const bf16x8 qf0 = *(const bf16x8*)(Qg + qoff + quad * 8);
    const bf16x8 qf1 = *(const bf16x8*)(Qg + qoff + 32 + quad * 8);
    f32x4 sc[9];
#pragma unroll
    for (int t = 0; t < 9; t++) {
      const bf16_t* krow = Ks + ((wave + t) * 16 + c16) * 72 + quad * 8;
      const bf16x8 a0 = *(const bf16x8*)krow;
      const bf16x8 a1 = *(const bf16x8*)(krow + 32);
      f32x4 s = (f32x4){0.f, 0.f, 0.f, 0.f};
      s = __builtin_amdgcn_mfma_f32_16x16x32_bf16(a0, qf0, s, 0, 0, 0);
      s = __builtin_amdgcn_mfma_f32_16x16x32_bf16(a1, qf1, s, 0, 0, 0);
      sc[t] = s;
    }
    float m = -1e30f;
#pragma unroll
    for (int t = 0; t < 9; t++)
#pragma unroll
      for (int j = 0; j < 4; j++) {
        const int kl = (wave + t) * 16 + quad * 4 + j;
        const int diff = 128 + wave * 16 + c16 - kl;
        const int lp = (n - 1) * 128 + kl;
        const bool valid = (diff >= 0) && (diff <= 128) && (lp >= 0);
        const float v = valid ? sc[t][j] : -1e30f;
        sc[t][j] = v;
        m = fmaxf(m, v);
      }
    m = fmaxf(m, __shfl_xor(m, 16));
    m = fmaxf(m, __shfl_xor(m, 32));
    float l = 0.f;
#pragma unroll
    for (int t = 0; t < 9; t++)
#pragma unroll
      for (int j = 0; j < 4; j++) {
        const float pv = __expf(sc[t][j] - m);
        sc[t][j] = pv;
        l += pv;
      }
    l += __shfl_xor(l, 16);
    l += __shfl_xor(l, 32);
    f32x4 o[4];
#pragma unroll
    for (int mt = 0; mt < 4; mt++) o[mt] = (f32x4){0.f, 0.f, 0.f, 0.f};
#pragma unroll
    for (int pr = 0; pr < 5; pr++) {
      const int ta = 2 * pr;
      const int tb = (pr < 4) ? (2 * pr + 1) : ta;
      union { bf16x8 v; unsigned u[4]; } pf;
      pf.u[0] = pack2(sc[ta][0], sc[ta][1]);
      pf.u[1] = pack2(sc[ta][2], sc[ta][3]);
      if (pr < 4) {
        pf.u[2] = pack2(sc[tb][0], sc[tb][1]);
        pf.u[3] = pack2(sc[tb][2], sc[tb][3]);
      } else {
        pf.u[2] = 0; pf.u[3] = 0;
      }
      const int kla = (wave + ta) * 16 + quad * 4;
      const int klb = (wave + tb) * 16 + quad * 4;
#pragma unroll
      for (int mt = 0; mt < 4; mt++) {
        const bf16_t* vr = Vt + (mt * 16 + c16) * 264;
        union { bf16x8 v; uint2 u[2]; } vf;
        vf.u[0] = *(const uint2*)(vr + kla);
        vf.u[1] = *(const uint2*)(vr + klb);
        o[mt] = __builtin_amdgcn_mfma_f32_16x16x32_bf16(vf.v, pf.v, o[mt], 0, 0, 0);
      }
    }
    const float inv = 1.0f / l;
#pragma unroll
    for (int mt = 0; mt < 4; mt++) {
      *(uint2*)(Qg + qoff + mt * 16 + quad * 4) =
          make_uint2(pack2(o[mt][0] * inv, o[mt][1] * inv), pack2(o[mt][2] * inv, o[mt][3] * inv));
    }
    if (quad == 0) ML[((size_t)g * T_TOK + tokb + posq) * 16 + h] = make_float2(m, l);
    __syncthreads();
  }
}

template <int ph>
__device__ __forceinline__ void run_phase(const Params& p, unsigned char* lds) {
  unsigned char* ws = p.ws;
  unsigned char* dob = (unsigned char*)p.out;
  const float* cs = (const float*)(ws + OFF_ROPE);
  const float* sn = cs + 65536;
  switch (ph) {
    case 0: phase_prep(p, lds); break;
    case 1: phase_mix(p); break;
    case 2: {
      const bf16_t* XS[4] = {(const bf16_t*)dob, (const bf16_t*)(dob + SLOT), (const bf16_t*)(ws + 2 * SLOT), (const bf16_t*)(ws + 7 * SLOT)};
      for (int idx = blockIdx.x; idx < 64 * 25; idx += gridDim.x) {
        const int m = idx / 25, n = idx % 25;
        if (n < 24) {
          const int pp = n >> 3;
          const bf16_t* A = (pp == 0) ? XS[0] : (pp == 1) ? XS[1] : XS[2];
          GemmArgs g{A, A, 1024, 1024, (const bf16_t*)(ws + OFF_WT_AIN), 1024, 1024};
          EpiStoreBf16 e{(bf16_t*)(ws + 4 * SLOT), 3072, 0};
          gemm_tile(g, m * 256, n * 128, lds, e);
        } else {
          GemmArgs g{(const bf16_t*)(ws + 1 * SLOT), (const bf16_t*)(ws + 3 * SLOT), 1024, 1024, (const bf16_t*)(ws + OFF_WT_LORA1), 2048, 2048};
          EpiLora1 e{(bf16_t*)(ws + OFF_SPARE)};
          gemm_tile(g, m * 256, 0, lds, e);
        }
      }
    } break;
    case 3: {
      for (int idx = blockIdx.x; idx < 64 * 16; idx += gridDim.x) {
        const int m = idx >> 4, n = idx & 15;
        const bf16_t* LO1 = (const bf16_t*)(ws + OFF_SPARE);
        if (n < 8) {
          GemmArgs g{LO1, LO1, 64, 128, (const bf16_t*)(ws + OFF_WT_W2), 64, 64};
          EpiLora2W e{(float*)dob, p.in[7]};
          gemm_tile(g, m * 256, n * 128, lds, e);
        } else {
          GemmArgs g{LO1 + 64, LO1 + 64, 64, 128, (const bf16_t*)(ws + OFF_WT_A2), 64, 64};
          EpiLora2A e{(bf16_t*)(ws + 1 * SLOT), p.in[10]};
          gemm_tile(g, m * 256, (n - 8) * 128, lds, e);
        }
      }
    } break;
    case 4: phase_scan(p, lds); break;
    case 5: {
      for (int idx = blockIdx.x; idx < 64 * 8; idx += gridDim.x) {
        const int m = idx >> 3, n = idx & 7;
        const bf16_t* XS3 = (const bf16_t*)(ws + 7 * SLOT);
        GemmArgs g{XS3, XS3, 1024, 1024, (const bf16_t*)(ws + OFF_WT_AIN) + (size_t)3072 * 1024, 1024, 1024};
        EpiGPost e{(const float*)(ws + 2 * SLOT), (const bf16_t*)(ws + 4 * SLOT), (const bf16_t*)(ws + 1 * SLOT),
                   p.in[14], p.in[15], p.in[16], p.in[17], (bf16_t*)dob};
        gemm_tile(g, m * 256, n * 128, lds, e);
      }
    } break;
    case 6: {
      for (int idx = blockIdx.x; idx < 64 * 8; idx += gridDim.x) {
        const int m = idx >> 3, n = idx & 7;
        const bf16_t* A4 = (const bf16_t*)dob;
        GemmArgs g{A4, A4, 1024, 1024, (const bf16_t*)(ws + OFF_WT_AOUT), 1024, 1024};
        EpiResidual e{p.in[0], (const float*)(ws + OFF_MODA) + 2048, (float*)(ws + 2 * SLOT)};
        gemm_tile(g, m * 256, n * 128, lds, e);
      }
    } break;
    case 7: phase_norm2(p); break;
    case 8: {
      for (int idx = blockIdx.x; idx < 64 * 40; idx += gridDim.x) {
        const int m = idx / 40, n = idx % 40;
        if (n < 16) {
          const bf16_t* A1 = (const bf16_t*)(ws + 4 * SLOT);
          GemmArgs g{A1, A1, 1024, 1024, (const bf16_t*)(ws + OFF_WT_KV), 1024, 1024};
          EpiKV e{(bf16_t*)(ws + 6 * SLOT), (bf16_t*)(ws + 7 * SLOT), p.in[21], cs, sn};
          gemm_tile(g, m * 256, n * 128, lds, e);
        } else {
          const bf16_t* A2 = (const bf16_t*)(ws + 5 * SLOT);
          GemmArgs g{A2, A2, 1024, 1024, (const bf16_t*)(ws + OFF_WT_BIN), 1024, 1024};
          EpiQ e{(bf16_t*)dob, (bf16_t*)(dob + SLOT), (bf16_t*)(ws + 1 * SLOT), p.in[26], cs, sn};
          gemm_tile(g, m * 256, (n - 16) * 128, lds, e);
        }
      }
    } break;
    case 9: phase_attn(p, lds); break;
    case 10: {
      for (int idx = blockIdx.x; idx < 64 * 8; idx += gridDim.x) {
        const int m = idx >> 3, n = idx & 7;
        const bf16_t* A2 = (const bf16_t*)(ws + 5 * SLOT);
        GemmArgs g{A2, A2, 1024, 1024, (const bf16_t*)(ws + OFF_WT_BIN) + (size_t)3072 * 1024, 1024, 1024};
        EpiMerge e{(const bf16_t*)dob, (const bf16_t*)(dob + SLOT), (const bf16_t*)(ws + 1 * SLOT), (const float2*)(ws + OFF_SPARE), (bf16_t*)(ws + 4 * SLOT)};
        gemm_tile(g, m * 256, n * 128, lds, e);
      }
    } break;
    case 11: {
      for (int idx = blockIdx.x; idx < 64 * 8; idx += gridDim.x) {
        const int m = idx >> 3, n = idx & 7;
        const bf16_t* A7 = (const bf16_t*)(ws + 4 * SLOT);
        GemmArgs g{A7, A7, 1024, 1024, (const bf16_t*)(ws + OFF_WT_BOUT), 1024, 1024};
        EpiResidual e{(const float*)(ws + 2 * SLOT), (const float*)(ws + OFF_MODB) + 2048, p.out};
        gemm_tile(g, m * 256, n * 128, lds, e);
      }
    } break;
    default: break;
  }
}

template <int PH>
__global__ void __launch_bounds__(NTHREADS) phase_kernel(Params p) {
  extern __shared__ __attribute__((aligned(16))) unsigned char lds[];
  run_phase<PH>(p, lds);
}

__global__ void __launch_bounds__(NTHREADS) mega_kernel(Params p) {
  extern __shared__ __attribute__((aligned(16))) unsigned char lds[];
  cg::grid_group grid = cg::this_grid();
  run_phase<0>(p, lds); grid.sync();
  run_phase<1>(p, lds); grid.sync();
  run_phase<2>(p, lds); grid.sync();
  run_phase<3>(p, lds); grid.sync();
  run_phase<4>(p, lds); grid.sync();
  run_phase<5>(p, lds); grid.sync();
  run_phase<6>(p, lds); grid.sync();
  run_phase<7>(p, lds); grid.sync();
  run_phase<8>(p, lds); grid.sync();
  run_phase<9>(p, lds); grid.sync();
  run_phase<10>(p, lds); grid.sync();
  run_phase<11>(p, lds);
}

template <int PH>
static void launch_phase(const Params& p, int grid, hipStream_t stream) {
  static bool attr = false;
  if (!attr) { (void)hipFuncSetAttribute((const void*)phase_kernel<PH>, hipFuncAttributeMaxDynamicSharedMemorySize, LDS_BYTES); attr = true; }
  hipLaunchKernelGGL(phase_kernel<PH>, dim3(grid), dim3(NTHREADS), LDS_BYTES, stream, p);
}

extern "C" void kernel_launch(void* const* d_in, const int* in_sizes, int n_in, void* d_out, int out_size, void* d_ws,
                              size_t ws_size, hipStream_t stream) {
  static int grid = 0;
  if (grid == 0) {
    int dev = 0, cus = 0;
    if (n_in != 28 || out_size != T_TOK * DM || ws_size < 256 * MiB) {
      fprintf(stderr, "kernel_launch: unexpected shapes n_in=%d out=%d ws=%zu\n", n_in, out_size, ws_size);
      grid = -1;
      return;
    }
    (void)hipGetDevice(&dev);
    (void)hipDeviceGetAttribute(&cus, hipDeviceAttributeMultiprocessorCount, dev);
    (void)hipFuncSetAttribute((const void*)mega_kernel, hipFuncAttributeMaxDynamicSharedMemorySize, LDS_BYTES);
    int per_cu = 0;
    (void)hipOccupancyMaxActiveBlocksPerMultiprocessor(&per_cu, (const void*)mega_kernel, NTHREADS, LDS_BYTES);
    if (per_cu < 1) fprintf(stderr, "kernel_launch: occupancy query says %d blocks/CU\n", per_cu);
    (void)hipGetLastError();
    grid = cus > 0 ? cus : 256;
  }
  if (grid < 0) return;
  Params p{};
  for (int i = 0; i < 28; i++) p.in[i] = (const float*)d_in[i];
  p.out = (float*)d_out;
  p.ws = (unsigned char*)d_ws;
#if ONE_LAUNCH
  void* args[] = {&p};
  hipError_t e = hipLaunchCooperativeKernel((const void*)mega_kernel, dim3(grid), dim3(NTHREADS), args, LDS_BYTES, stream);
  if (e != hipSuccess) fprintf(stderr, "cooperative launch failed: %s (grid %d)\n", hipGetErrorString(e), grid);
#else
  launch_phase<0>(p, grid, stream); launch_phase<1>(p, grid, stream); launch_phase<2>(p, grid, stream);
  launch_phase<3>(p, grid, stream); launch_phase<4>(p, grid, stream); launch_phase<5>(p, grid, stream);
  launch_phase<6>(p, grid, stream); launch_phase<7>(p, grid, stream); launch_phase<8>(p, grid, stream);
  launch_phase<9>(p, grid, stream); launch_phase<10>(p, grid, stream); launch_phase<11>(p, grid, stream);
#endif
}
```

```cpp
#include <hip/hip_runtime.h>
#include <hip/hip_cooperative_groups.h>
#include <cstdio>
#include <cstdint>
namespace cg = cooperative_groups;

#ifndef PROBE_DOUBLE
#define PROBE_DOUBLE -1
#endif
#ifndef ONE_LAUNCH
#define ONE_LAUNCH 1
#endif

typedef __attribute__((ext_vector_type(8))) short bf16x8;
typedef __attribute__((ext_vector_type(4))) float f32x4;
typedef unsigned short bf16_t;

constexpr int T_TOK = 16384;
constexpr int DM = 1024;
constexpr int SEQ = 2048;
constexpr int NTHREADS = 512;
constexpr int LDS_BYTES = 131072 + 16;
constexpr int N_PHASES = 12;

constexpr size_t MiB = 1ull << 20;
constexpr size_t OFF_WT_AIN = 0;
constexpr size_t OFF_WT_LORA1 = OFF_WT_AIN + 8 * MiB;
constexpr size_t OFF_WT_W2 = OFF_WT_LORA1 + 512 * 1024;
constexpr size_t OFF_WT_A2 = OFF_WT_W2 + 128 * 1024;
constexpr size_t OFF_WT_AOUT = OFF_WT_A2 + 128 * 1024;
constexpr size_t OFF_WT_KV = OFF_WT_AOUT + 2 * MiB;
constexpr size_t OFF_WT_BIN = OFF_WT_KV + 4 * MiB;
constexpr size_t OFF_WT_BOUT = OFF_WT_BIN + 8 * MiB;
constexpr size_t OFF_MODA = OFF_WT_BOUT + 2 * MiB;
constexpr size_t OFF_MODB = OFF_MODA + 96 * 1024;
constexpr size_t OFF_ROPE = OFF_MODB + 96 * 1024;
constexpr size_t OFF_SPARE = OFF_ROPE + 512 * 1024;
static_assert(OFF_SPARE + 6 * MiB <= 32 * MiB, "slot0 overflow");
constexpr size_t SLOT = 32 * MiB;

struct Params {
  const float* in[28];
  float* out;
  unsigned char* ws;
};

__device__ __forceinline__ float bf2f(unsigned short b) { return __uint_as_float(((unsigned)b) << 16); }
__device__ __forceinline__ unsigned short f2bf(float f) {
  unsigned u = __float_as_uint(f);
  u += 0x7FFFu + ((u >> 16) & 1u);
  return (unsigned short)(u >> 16);
}
typedef __bf16 bf16x2_t __attribute__((ext_vector_type(2)));
typedef float f32x2_t __attribute__((ext_vector_type(2)));
__device__ __forceinline__ unsigned pack2(float a, float b) {
  const f32x2_t f = {a, b};
  return __builtin_bit_cast(unsigned, __builtin_convertvector(f, bf16x2_t));
}
__device__ __forceinline__ float lo_bf(unsigned u) { return __uint_as_float(u << 16); }
__device__ __forceinline__ float hi_bf(unsigned u) { return __uint_as_float(u & 0xFFFF0000u); }

template <int CTRL>
__device__ __forceinline__ float dpp_f(float v) {
  return __builtin_bit_cast(float, __builtin_amdgcn_update_dpp(0, __builtin_bit_cast(int, v), CTRL, 0xF, 0xF, false));
}
#define DPP_ADD(r, ctl) "v_add_f32_dpp " r ", " r ", " r " " ctl " row_mask:0xf bank_mask:0xf\n\t"
__device__ __forceinline__ float row16_sum(float v) {
  asm("s_nop 1\n\t" DPP_ADD("%0", "quad_perm:[1,0,3,2]") "s_nop 1\n\t" DPP_ADD("%0", "quad_perm:[2,3,0,1]") "s_nop 1\n\t"
      DPP_ADD("%0", "row_half_mirror") "s_nop 1\n\t" DPP_ADD("%0", "row_mirror")
      : "+v"(v));
  return v;
}
__device__ __forceinline__ void row16_sum3(float& a, float& b, float& c) {
  asm("s_nop 1\n\t"
      DPP_ADD("%0", "quad_perm:[1,0,3,2]") DPP_ADD("%1", "quad_perm:[1,0,3,2]") DPP_ADD("%2", "quad_perm:[1,0,3,2]")
      DPP_ADD("%0", "quad_perm:[2,3,0,1]") DPP_ADD("%1", "quad_perm:[2,3,0,1]") DPP_ADD("%2", "quad_perm:[2,3,0,1]")
      DPP_ADD("%0", "row_half_mirror") DPP_ADD("%1", "row_half_mirror") DPP_ADD("%2", "row_half_mirror")
      DPP_ADD("%0", "row_mirror") DPP_ADD("%1", "row_mirror") DPP_ADD("%2", "row_mirror")
      : "+v"(a), "+v"(b), "+v"(c));
}
__device__ __forceinline__ void row16_sum4(float& a, float& b, float& c, float& d) {
  asm("s_nop 1\n\t"
      DPP_ADD("%0", "quad_perm:[1,0,3,2]") DPP_ADD("%1", "quad_perm:[1,0,3,2]") DPP_ADD("%2", "quad_perm:[1,0,3,2]") DPP_ADD("%3", "quad_perm:[1,0,3,2]")
      DPP_ADD("%0", "quad_perm:[2,3,0,1]") DPP_ADD("%1", "quad_perm:[2,3,0,1]") DPP_ADD("%2", "quad_perm:[2,3,0,1]") DPP_ADD("%3", "quad_perm:[2,3,0,1]")
      DPP_ADD("%0", "row_half_mirror") DPP_ADD("%1", "row_half_mirror") DPP_ADD("%2", "row_half_mirror") DPP_ADD("%3", "row_half_mirror")
      DPP_ADD("%0", "row_mirror") DPP_ADD("%1", "row_mirror") DPP_ADD("%2", "row_mirror") DPP_ADD("%3", "row_mirror")
      : "+v"(a), "+v"(b), "+v"(c), "+v"(d));
}
__device__ __forceinline__ float wave_sum(float v) {
#pragma unroll
  for (int o = 32; o >= 1; o >>= 1) v += __shfl_xor(v, o);
  return v;
}
__device__ __forceinline__ int opaque_tid() { int t = threadIdx.x; asm volatile("" : "+v"(t)); return t; }
__device__ __forceinline__ float sigmoidf_(float x) { return __builtin_amdgcn_rcpf(1.0f + __expf(-x)); }

#define XB_TMO      128
#define XB_XCNT(j)  (256  + 64 * (j))
#define XB_XSUB(j)  (1280 + 64 * (j))
#define XB_XGEN(j)  (2304 + 64 * (j))
#define XB_TOP      3328
#define XB_TOPGEN   3392
#define XCD_BAR_WORDS 3456
#define XB_SPIN_CAP (1u << 20)
#define LAS __attribute__((address_space(3)))
constexpr size_t OFF_BAR = SLOT - 16384;
constexpr size_t OFF_PANEL = OFF_BAR + 14336;
static_assert(XCD_BAR_WORDS * 4 <= 16384, "barrier words");
__device__ __forceinline__ unsigned xb_ld(unsigned* p) { return __hip_atomic_load(p, __ATOMIC_RELAXED, __HIP_MEMORY_SCOPE_AGENT); }
__device__ __forceinline__ unsigned xb_add(unsigned* p, unsigned v) { return __hip_atomic_fetch_add(p, v, __ATOMIC_RELAXED, __HIP_MEMORY_SCOPE_AGENT); }
__device__ __forceinline__ unsigned xb_xcc_id() { return (unsigned)__builtin_amdgcn_s_getreg((3 << 11) | 20) & 0xFu; }
#define XB_SPIN(cond, bar) do { unsigned _sp = 0; while (cond) { __builtin_amdgcn_s_sleep(1); \
    if ((++_sp & 255u) == 0u) { if (xb_ld(&(bar)[XB_TMO])) break; if (_sp > XB_SPIN_CAP) { atomicAdd(&(bar)[XB_TMO], 1u); break; } } } } while (0)
struct XcdBarrier { unsigned* bar; unsigned x; volatile LAS unsigned* st; };
__device__ __forceinline__ XcdBarrier xcd_barrier_post(unsigned* bar, volatile LAS unsigned* st) {
  XcdBarrier b; b.bar = bar; b.x = xb_xcc_id(); b.st = st;
  if (threadIdx.x == 0) (void)xb_add(&bar[XB_XCNT(b.x)], 1u);
  return b;
}
__device__ __forceinline__ void xcd_barrier_complete(unsigned* bar, unsigned x, unsigned& nloc, unsigned& nx) {
  const unsigned G = gridDim.x * gridDim.y * gridDim.z;
  unsigned sum, cnt, mine, sp = 0u;
  for (;;) {
    sum = 0u; cnt = 0u; mine = 0u;
#pragma unroll
    for (unsigned j = 0; j < 16; ++j) { const unsigned c = xb_ld(&bar[XB_XCNT(j)]); sum += c; cnt += (c > 0u) ? 1u : 0u; mine = (j == x) ? c : mine; }
    if (sum == G) break;
    __builtin_amdgcn_s_sleep(1);
    if ((++sp & 255u) == 0u) { if (xb_ld(&bar[XB_TMO])) break; if (sp > XB_SPIN_CAP) { atomicAdd(&bar[XB_TMO], 1u); break; } }
  }
  nloc = mine > 0u ? mine : 1u; nx = cnt > 0u ? cnt : 1u;
}
__device__ __forceinline__ void xcd_barrier(const XcdBarrier& b) {
  asm volatile("s_waitcnt vmcnt(0)" ::: "memory");
  __syncthreads();
  if (threadIdx.x == 0) {
    unsigned* bar = b.bar;
    __builtin_amdgcn_s_waitcnt(0);
    unsigned nloc = b.st[0], nx = b.st[1];
    if (nloc == 0u) { xcd_barrier_complete(bar, b.x, nloc, nx); b.st[0] = nloc; b.st[1] = nx; }
    const unsigned old = xb_add(&bar[XB_XSUB(b.x)], 1u);
    const unsigned gen = old / nloc;
    if (old + 1u == (gen + 1u) * nloc) {
      __builtin_amdgcn_fence(__ATOMIC_RELEASE, "agent");
      asm volatile("s_waitcnt vmcnt(0)" ::: "memory");
      const unsigned og = xb_add(&bar[XB_TOP], 1u);
      const unsigned tg = og / nx;
      if (og + 1u == (tg + 1u) * nx) xb_add(&bar[XB_TOPGEN], 1u);
      else XB_SPIN(xb_ld(&bar[XB_TOPGEN]) == tg, bar);
      __builtin_amdgcn_fence(__ATOMIC_ACQUIRE, "agent");
      xb_add(&bar[XB_XGEN(b.x)], 1u);
      asm volatile("s_waitcnt vmcnt(0)" ::: "memory");
    } else {
      XB_SPIN(xb_ld(&bar[XB_XGEN(b.x)]) == gen, bar);
      __builtin_amdgcn_fence(__ATOMIC_ACQUIRE, "agent");
      asm volatile("s_waitcnt vmcnt(0)" ::: "memory");
    }
  }
  __syncthreads();
}

__device__ __forceinline__ void transpose_tile(const float* __restrict__ src, int ld_src, int k0, int n0, bf16_t* __restrict__ dst, int ld_dst,
                               int ndst0, int kdst0, const float* __restrict__ scale, float* sm, const float* __restrict__ scale_sub = nullptr) {
  const int tid = opaque_tid();
#pragma unroll
  for (int i = 0; i < 8; i++) {
    int k = (tid >> 6) + i * 8, n = tid & 63;
    float v = src[(size_t)(k0 + k) * ld_src + n0 + n];
    if (scale) v *= (scale_sub ? (scale[k0 + k] - scale_sub[k0 + k]) : scale[k0 + k]);
    sm[k * 65 + n] = v;
  }
  __syncthreads();
#pragma unroll
  for (int i = 0; i < 2; i++) {
    const int kk = tid & 15, n = (tid >> 4) + i * 32;
    const float* sp = sm + (kk * 4) * 65 + n;
    *(uint2*)(dst + (size_t)(ndst0 + n) * ld_dst + kdst0 + kk * 4) = make_uint2(pack2(sp[0], sp[65]), pack2(sp[130], sp[195]));
  }
  __syncthreads();
}

__device__ __forceinline__ void phase_prep(const Params& p, unsigned char* lds, int u_lo, int u_hi) {
  const int tid = opaque_tid();
  float* sm = (float*)lds;
  unsigned char* ws = p.ws;
  for (int u = u_lo + blockIdx.x; u < u_hi; u += gridDim.x) {
    if (u < 384) {
      const int layer = u / 192, j0 = (u % 192) * 16;
      const float* c = p.in[1];
      const float* W = layer ? p.in[22] : p.in[2];
      const float* bias = layer ? p.in[23] : p.in[3];
      float* mod = (float*)(ws + (layer ? OFF_MODB : OFF_MODA));
      float* sc = sm;
      float* red = sm + 8192;
      for (int i = tid; i < 8192; i += NTHREADS) { float cv = c[i]; sc[i] = cv * __builtin_amdgcn_rcpf(1.0f + __expf(-cv)); }
      __syncthreads();
      const int cl = tid & 15, ds = tid >> 4;
      float acc[8];
#pragma unroll
      for (int b = 0; b < 8; b++) acc[b] = 0.f;
      float wr[32];
#pragma unroll
      for (int i = 0; i < 32; i++) wr[i] = W[(size_t)(ds * 32 + i) * 3072 + j0 + cl];
#pragma unroll
      for (int i = 0; i < 32; i++) {
        const int d = ds * 32 + i;
#pragma unroll
        for (int b = 0; b < 8; b++) acc[b] += sc[b * 1024 + d] * wr[i];
      }
#pragma unroll
      for (int b = 0; b < 8; b++) red[(ds * 8 + b) * 16 + cl] = acc[b];
      __syncthreads();
      if (tid < 128) {
        const int b = tid >> 4;
        float s = bias[j0 + cl];
#pragma unroll
        for (int d2 = 0; d2 < 32; d2++) s += red[(d2 * 8 + b) * 16 + cl];
        mod[b * 3072 + j0 + cl] = s;
      }
      __syncthreads();
    } else if (u < 512) {
      const int idx = (u - 384) * 512 + tid;
      const int pos = idx >> 5, i = idx & 31;
      float invf = exp2f(-((float)i * (1.0f / 32.0f)) * 13.287712379549449f);
      float angf = (float)pos * invf;
      double rev = (double)angf * 0.15915494309189535;
      rev -= floor(rev);
      float rv = (float)rev;
      float* cs = (float*)(ws + OFF_ROPE);
      cs[idx] = __builtin_amdgcn_cosf(rv);
      cs[65536 + idx] = __builtin_amdgcn_sinf(rv);
    } else {
      int t = u - 512;
      if (t < 1024) {
        transpose_tile(p.in[6], 4096, (t & 15) * 64, (t >> 4) * 64, (bf16_t*)(ws + OFF_WT_AIN), 1024, (t >> 4) * 64, (t & 15) * 64, nullptr, sm);
      } else if ((t -= 1024) < 64) {
        const int job = t >> 4, kt = t & 15;
        const float* src = (job < 2) ? p.in[8] : p.in[11];
        const float* scale = (job == 1) ? (p.in[5] + 4 * 1024) : (job == 3) ? (p.in[5] + 5 * 1024) : nullptr;
        transpose_tile(src, 64, kt * 64, 0, (bf16_t*)(ws + OFF_WT_LORA1), 2048, (job >> 1) * 64, ((job & 1) ? 1024 : 0) + kt * 64, scale, sm, p.in[5]);
      } else if ((t -= 64) < 32) {
        const int job = t >> 4, nt = t & 15;
        transpose_tile(job ? p.in[12] : p.in[9], 1024, 0, nt * 64, (bf16_t*)(ws + (job ? OFF_WT_A2 : OFF_WT_W2)), 64, nt * 64, 0, nullptr, sm);
      } else if ((t -= 32) < 256) {
        transpose_tile(p.in[18], 1024, (t & 15) * 64, (t >> 4) * 64, (bf16_t*)(ws + OFF_WT_AOUT), 1024, (t >> 4) * 64, (t & 15) * 64, nullptr, sm);
      } else if ((t -= 256) < 512) {
        transpose_tile(p.in[20], 2048, (t & 15) * 64, (t >> 4) * 64, (bf16_t*)(ws + OFF_WT_KV), 1024, (t >> 4) * 64, (t & 15) * 64, nullptr, sm);
      } else if ((t -= 512) < 1024) {
        transpose_tile(p.in[25], 4096, (t & 15) * 64, (t >> 4) * 64, (bf16_t*)(ws + OFF_WT_BIN), 1024, (t >> 4) * 64, (t & 15) * 64, nullptr, sm);
      } else {
        t -= 1024;
        transpose_tile(p.in[27], 1024, (t & 15) * 64, (t >> 4) * 64, (bf16_t*)(ws + OFF_WT_BOUT), 1024, (t >> 4) * 64, (t & 15) * 64, nullptr, sm);
      }
    }
  }
}

__device__ __forceinline__ void phase_mix(const Params& p) {
  const int tid_ = opaque_tid(); const int lane = tid_ & 63, wave = tid_ >> 6;
  unsigned char* ws = p.ws;
  const float* x = p.in[0];
  const float* ng = p.in[4];
  const float* mu = p.in[5];
  const float* modA = (const float*)(ws + OFF_MODA);
  bf16_t* H = (bf16_t*)(ws + 1 * SLOT);
  bf16_t* XX = (bf16_t*)(ws + 3 * SLOT);
  bf16_t* XS0 = (bf16_t*)((unsigned char*)p.out);
  bf16_t* XS1 = (bf16_t*)((unsigned char*)p.out + SLOT);
  bf16_t* XS2 = (bf16_t*)(ws + 2 * SLOT);
  bf16_t* XS3 = (bf16_t*)(ws + 7 * SLOT);
  for (int u = blockIdx.x; u < T_TOK / 8; u += gridDim.x) {
    const int t = u * 8 + wave;
    const int b = t >> 11, s = t & 2047;
    const float4* xr = (const float4*)(x + (size_t)t * DM);
    const float4* xp = (const float4*)(x + (size_t)(t - 1) * DM);
    float4 cur[4], prv[4];
    float ss = 0.f, ssp = 0.f;
#pragma unroll
    for (int i = 0; i < 4; i++) {
      cur[i] = xr[(i >> 1) * 128 + lane * 2 + (i & 1)];
      ss += cur[i].x * cur[i].x + cur[i].y * cur[i].y + cur[i].z * cur[i].z + cur[i].w * cur[i].w;
    }
    if (s > 0) {
#pragma unroll
      for (int i = 0; i < 4; i++) {
        prv[i] = xp[(i >> 1) * 128 + lane * 2 + (i & 1)];
        ssp += prv[i].x * prv[i].x + prv[i].y * prv[i].y + prv[i].z * prv[i].z + prv[i].w * prv[i].w;
      }
    } else {
#pragma unroll
      for (int i = 0; i < 4; i++) prv[i] = make_float4(0.f, 0.f, 0.f, 0.f);
    }
    ss = wave_sum(ss);
    ssp = wave_sum(ssp);
    const float rinv = __builtin_amdgcn_rsqf(ss * (1.0f / 1024.0f) + 1e-6f);
    const float rinvp = __builtin_amdgcn_rsqf(ssp * (1.0f / 1024.0f) + 1e-6f);
#pragma unroll
    for (int jp = 0; jp < 2; jp++) {
      const int d = jp * 512 + lane * 8;
      float hc[8], hx[8];
#pragma unroll
      for (int hf = 0; hf < 2; hf++) {
        const int i = jp * 2 + hf;
        const float4 g4 = *(const float4*)(ng + d + hf * 4);
        const float4 sh4 = *(const float4*)(modA + b * 3072 + d + hf * 4);
        const float4 sc4 = *(const float4*)(modA + b * 3072 + 1024 + d + hf * 4);
        const float cv[4] = {cur[i].x, cur[i].y, cur[i].z, cur[i].w};
        const float pv[4] = {prv[i].x, prv[i].y, prv[i].z, prv[i].w};
        const float gg[4] = {g4.x, g4.y, g4.z, g4.w};
        const float sh[4] = {sh4.x, sh4.y, sh4.z, sh4.w};
        const float sc[4] = {sc4.x, sc4.y, sc4.z, sc4.w};
#pragma unroll
        for (int e = 0; e < 4; e++) {
          float h = cv[e] * rinv * gg[e] * (1.0f + sc[e]) + sh[e];
          float hp = (s > 0) ? (pv[e] * rinvp * gg[e] * (1.0f + sc[e]) + sh[e]) : 0.f;
          hc[hf * 4 + e] = h;
          hx[hf * 4 + e] = hp - h;
        }
      }
      const size_t o = (size_t)t * DM + d;
      *(uint4*)(XX + o) = make_uint4(pack2(hx[0], hx[1]), pack2(hx[2], hx[3]), pack2(hx[4], hx[5]), pack2(hx[6], hx[7]));
#pragma unroll
      for (int q = 0; q < 4; q++) {
        const float4 m0 = *(const float4*)(mu + q * 1024 + d);
        const float4 m1 = *(const float4*)(mu + q * 1024 + d + 4);
        const float mm[8] = {m0.x, m0.y, m0.z, m0.w, m1.x, m1.y, m1.z, m1.w};
        float v[8];
#pragma unroll
        for (int e = 0; e < 8; e++) v[e] = hc[e] + hx[e] * mm[e];
        bf16_t* dst = (q == 0) ? XS0 : (q == 1) ? XS1 : (q == 2) ? XS2 : XS3;
        *(uint4*)(dst + o) = make_uint4(pack2(v[0], v[1]), pack2(v[2], v[3]), pack2(v[4], v[5]), pack2(v[6], v[7]));
      }
    }
  }
}

struct GemmArgs {
  const bf16_t* A0; const bf16_t* A1; int ksplit; int lda;
  const bf16_t* Bt; int ldb; int K;
};

constexpr int G_LDA = 64;
constexpr int G_ASTAGE = 256 * G_LDA;
constexpr int G_BSTAGE = 128 * G_LDA;
template <class Epi>
__device__ __forceinline__ void gemm_tile(const GemmArgs& g, int m0, int n0, unsigned char* lds, const Epi& epi) {
  const int tid = opaque_tid(), lane = tid & 63, wave = tid >> 6;
  const int wm = wave & 3, wn = wave >> 2;
  const int fr = lane & 15, fq = lane >> 4;
  bf16_t* As = (bf16_t*)lds;
  bf16_t* Bs = (bf16_t*)(lds + 2 * G_ASTAGE * 2);
  f32x4 acc[4][4];
#pragma unroll
  for (int i = 0; i < 4; i++)
#pragma unroll
    for (int j = 0; j < 4; j++) acc[i][j] = (f32x4){0.f, 0.f, 0.f, 0.f};
  const int lr = tid >> 3, lk = (tid & 7) * 8;
  const int lkw = ((tid & 7) ^ ((lr >> 1) & 7)) * 8;
  const int rsw = (fr >> 1) & 7;
  uint4 ra0_0, ra0_1, ra0_2, ra0_3, ra1_0, ra1_1, ra1_2, ra1_3, rb0_0, rb0_1, rb1_0, rb1_1;
  const int nk = g.K >> 6;
  const bf16_t* arow0 = g.A0 + (size_t)(m0 + lr) * g.lda + lk;
  const bf16_t* arow1 = g.A1 + (size_t)(m0 + lr) * g.lda + lk - g.ksplit;
  const bf16_t* brow = g.Bt + (size_t)(n0 + lr) * g.ldb + lk;
  const size_t a64 = (size_t)64 * g.lda, b64 = (size_t)64 * g.ldb;
#define G_LOAD(SET, KT)                                                                   \
  {                                                                                       \
    const int kg_ = (KT) * 64;                                                            \
    const bf16_t* ab_ = ((kg_ < g.ksplit) ? arow0 : arow1) + kg_;                         \
    ra##SET##_0 = *(const uint4*)(ab_);                                                   \
    ra##SET##_1 = *(const uint4*)(ab_ + a64);                                             \
    ra##SET##_2 = *(const uint4*)(ab_ + 2 * a64);                                         \
    ra##SET##_3 = *(const uint4*)(ab_ + 3 * a64);                                         \
    rb##SET##_0 = *(const uint4*)(brow + kg_);                                            \
    rb##SET##_1 = *(const uint4*)(brow + kg_ + b64);                                      \
  }
#define G_WRITE(SET, ST)                                                                  \
  {                                                                                       \
    bf16_t* aw_ = As + (ST) * G_ASTAGE + lr * G_LDA + lkw;                                \
    bf16_t* bw_ = Bs + (ST) * G_BSTAGE + lr * G_LDA + lkw;                                \
    *(uint4*)(aw_) = ra##SET##_0;                                                         \
    *(uint4*)(aw_ + 64 * G_LDA) = ra##SET##_1;                                            \
    *(uint4*)(aw_ + 128 * G_LDA) = ra##SET##_2;                                           \
    *(uint4*)(aw_ + 192 * G_LDA) = ra##SET##_3;                                           \
    *(uint4*)(bw_) = rb##SET##_0;                                                         \
    *(uint4*)(bw_ + 64 * G_LDA) = rb##SET##_1;                                            \
  }
#define G_COMPUTE(ST)                                                                     \
  {                                                                                       \
    const bf16_t* Asr_ = As + (ST) * G_ASTAGE + (wm * 64 + fr) * G_LDA;                   \
    const bf16_t* Bsr_ = Bs + (ST) * G_BSTAGE + (wn * 64 + fr) * G_LDA;                   \
    _Pragma("unroll") for (int ks_ = 0; ks_ < 2; ks_++) {                                 \
      bf16x8 a_[4], b_[4];                                                                \
      const int go_ = ((ks_ * 4 + fq) ^ rsw) * 8;                                         \
      _Pragma("unroll") for (int i_ = 0; i_ < 4; i_++) a_[i_] = *(const bf16x8*)(Asr_ + i_ * 16 * G_LDA + go_); \
      _Pragma("unroll") for (int i_ = 0; i_ < 4; i_++) b_[i_] = *(const bf16x8*)(Bsr_ + i_ * 16 * G_LDA + go_); \
      _Pragma("unroll") for (int i_ = 0; i_ < 4; i_++)                                    \
        _Pragma("unroll") for (int j_ = 0; j_ < 4; j_++)                                  \
          acc[i_][j_] = __builtin_amdgcn_mfma_f32_16x16x32_bf16(b_[j_], a_[i_], acc[i_][j_], 0, 0, 0); \
    }                                                                                     \
  }
  G_LOAD(0, 0);
  if (nk > 1) G_LOAD(1, 1);
  G_WRITE(0, 0);
  __syncthreads();
  for (int kt = 0; kt < nk; kt += 2) {
    if (kt + 2 < nk) G_LOAD(0, kt + 2);
    __builtin_amdgcn_sched_barrier(0);
    G_COMPUTE(0);
    if (kt + 1 < nk) G_WRITE(1, 1);
    __syncthreads();
    if (kt + 1 < nk) {
      if (kt + 3 < nk) G_LOAD(1, kt + 3);
      __builtin_amdgcn_sched_barrier(0);
      G_COMPUTE(1);
      if (kt + 2 < nk) G_WRITE(0, 0);
      __syncthreads();
    }
  }
#undef G_LOAD
#undef G_WRITE
#undef G_COMPUTE
  epi(acc, m0 + wm * 64, n0 + wn * 64, fr, fq);
}

constexpr int G2_STAGE = 256 * G_LDA;
template <class Epi>
__device__ __forceinline__ void gemm_tile256(const GemmArgs& g, int m0, int n0, unsigned char* lds, const Epi& epi) {
  const int tid = opaque_tid(), lane = tid & 63, wave = tid >> 6;
  const int wm = wave & 1, wn = wave >> 1;
  const int fr = lane & 15, fq = lane >> 4;
  bf16_t* As = (bf16_t*)lds;
  bf16_t* Bs = (bf16_t*)(lds + 2 * G2_STAGE * 2);
  f32x4 acc[2][4][4];
#pragma unroll
  for (int h = 0; h < 2; h++)
#pragma unroll
    for (int i = 0; i < 4; i++)
#pragma unroll
      for (int j = 0; j < 4; j++) acc[h][i][j] = (f32x4){0.f, 0.f, 0.f, 0.f};
  const int lr = tid >> 3;
  const int lkg = ((tid & 7) ^ ((lr >> 1) & 7)) * 8;
  const int rsw = (fr >> 1) & 7;
  const int nk = g.K >> 6;
  const bf16_t* arow0 = g.A0 + (size_t)(m0 + lr) * g.lda + lkg;
  const bf16_t* arow1 = g.A1 + (size_t)(m0 + lr) * g.lda + lkg - g.ksplit;
  const int lrp = (lr & ~31) + 8 * ((lr & 15) >> 2) + 4 * ((lr >> 4) & 1) + (lr & 3);
  const bf16_t* brow = g.Bt + (size_t)(n0 + lrp) * g.ldb + lkg;
  const size_t a64 = (size_t)64 * g.lda, b64 = (size_t)64 * g.ldb;
  bf16_t* lds_a = As + tid * 8;
  bf16_t* lds_b = Bs + tid * 8;
#define G2_STAGE_IN(KT, ST)                                                               \
  {                                                                                       \
    const int kg_ = (KT) * 64;                                                            \
    const bf16_t* ab_ = ((kg_ < g.ksplit) ? arow0 : arow1) + kg_;                         \
    _Pragma("unroll") for (int i_ = 0; i_ < 4; i_++) {                                    \
      __builtin_amdgcn_global_load_lds((const unsigned*)(ab_ + i_ * a64), (unsigned*)(lds_a + (ST) * G2_STAGE + i_ * 64 * G_LDA), 16, 0, 0); \
      __builtin_amdgcn_global_load_lds((const unsigned*)(brow + kg_ + i_ * b64), (unsigned*)(lds_b + (ST) * G2_STAGE + i_ * 64 * G_LDA), 16, 0, 0); \
    }                                                                                     \
  }
#define G2_COMPUTE(ST)                                                                    \
  {                                                                                       \
    const bf16_t* Asr_ = As + (ST) * G2_STAGE + (wm * 128 + fr) * G_LDA;                  \
    const bf16_t* Bsr_ = Bs + (ST) * G2_STAGE + (wn * 64 + fr) * G_LDA;                   \
    const int go0_ = ((0 + fq) ^ rsw) * 8, go1_ = ((4 + fq) ^ rsw) * 8;                   \
    bf16x8 bb_[2][4], aa_[16];                                                            \
    _Pragma("unroll") for (int i_ = 0; i_ < 4; i_++) bb_[0][i_] = *(const bf16x8*)(Bsr_ + i_ * 16 * G_LDA + go0_); \
    _Pragma("unroll") for (int q_ = 0; q_ < 3; q_++) aa_[q_] = *(const bf16x8*)(Asr_ + (((q_ >> 2) & 1) * 64 + (q_ & 3) * 16) * G_LDA + go0_); \
    _Pragma("unroll") for (int q_ = 0; q_ < 16; q_++) {                                   \
      if (q_ + 3 < 16) {                                                                  \
        const int p_ = q_ + 3;                                                            \
        aa_[p_] = *(const bf16x8*)(Asr_ + (((p_ >> 2) & 1) * 64 + (p_ & 3) * 16) * G_LDA + ((p_ >> 3) ? go1_ : go0_)); \
      }                                                                                   \
      if (q_ == 4) {                                                                      \
        _Pragma("unroll") for (int i_ = 0; i_ < 4; i_++) bb_[1][i_] = *(const bf16x8*)(Bsr_ + i_ * 16 * G_LDA + go1_); \
      }                                                                                   \
      __builtin_amdgcn_sched_barrier(0);                                                  \
      _Pragma("unroll") for (int j_ = 0; j_ < 4; j_++)                                    \
        acc[(q_ >> 2) & 1][q_ & 3][j_] = __builtin_amdgcn_mfma_f32_16x16x32_bf16(bb_[q_ >> 3][j_], aa_[q_], acc[(q_ >> 2) & 1][q_ & 3][j_], 0, 0, 0); \
      __builtin_amdgcn_sched_barrier(0);                                                  \
    }                                                                                     \
  }
  G2_STAGE_IN(0, 0);
  asm volatile("s_waitcnt vmcnt(0)" ::: "memory");
  __syncthreads();
  for (int kt = 0; kt < nk; kt++) {
    const int st = kt & 1;
    if (kt + 1 < nk) G2_STAGE_IN(kt + 1, st ^ 1);
    G2_COMPUTE(st);
    asm volatile("s_waitcnt vmcnt(0)" ::: "memory");
    __syncthreads();
  }
#undef G2_STAGE_IN
#undef G2_COMPUTE
  epi(acc[0], m0 + wm * 128, n0 + wn * 64, fr, fq);
  __builtin_amdgcn_sched_barrier(0);
  epi(acc[1], m0 + wm * 128 + 64, n0 + wn * 64, fr, fq);
}

__device__ __forceinline__ uint2 pack4(float a, float b, float c, float d) { return make_uint2(pack2(a, b), pack2(c, d)); }
__device__ __forceinline__ float quad_sum(float v) {
  v += __shfl_xor(v, 16);
  v += __shfl_xor(v, 32);
  return v;
}
#define PCOL(ni) (((ni) >> 1) * 32 + fq * 8 + ((ni) & 1) * 4)
struct EpiStoreBf16 {
  bf16_t* dst; int ldd; int coff;
  __device__ __forceinline__ void operator()(f32x4 (&acc)[4][4], int m0w, int n0w, int fr, int fq) const {
#pragma unroll
    for (int mi = 0; mi < 4; mi++) {
      const size_t row = m0w + mi * 16 + fr;
#pragma unroll
      for (int pp = 0; pp < 2; pp++) {
        const uint2 lo = pack4(acc[mi][2 * pp][0], acc[mi][2 * pp][1], acc[mi][2 * pp][2], acc[mi][2 * pp][3]);
        const uint2 hi = pack4(acc[mi][2 * pp + 1][0], acc[mi][2 * pp + 1][1], acc[mi][2 * pp + 1][2], acc[mi][2 * pp + 1][3]);
        *(uint4*)(dst + row * ldd + coff + n0w + pp * 32 + fq * 8) = make_uint4(lo.x, lo.y, hi.x, hi.y);
      }
    }
  }
};
struct EpiLora1 {
  bf16_t* dst;
  __device__ __forceinline__ void operator()(f32x4 (&acc)[4][4], int m0w, int n0w, int fr, int fq) const {
#pragma unroll
    for (int mi = 0; mi < 4; mi++) {
      const size_t row = m0w + mi * 16 + fr;
#pragma unroll
      for (int ni = 0; ni < 4; ni++) {
        float v[4];
#pragma unroll
        for (int j = 0; j < 4; j++) { v[j] = acc[mi][ni][j]; if (n0w < 64) v[j] = 2.0f * __builtin_amdgcn_rcpf(1.0f + __expf(-2.0f * v[j])) - 1.0f;     }
        *(uint2*)(dst + row * 128 + n0w + ni * 16 + fq * 4) = pack4(v[0], v[1], v[2], v[3]);
      }
    }
  }
};
struct EpiLora2W {
  bf16_t* dst; const float* w0;
  __device__ __forceinline__ void operator()(f32x4 (&acc)[4][4], int m0w, int n0w, int fr, int fq) const {
#pragma unroll
    for (int ni = 0; ni < 4; ni++) {
      const int col = n0w + ni * 16 + fq * 4;
      const float4 bias = *(const float4*)(w0 + col);
#pragma unroll
      for (int mi = 0; mi < 4; mi++) {
        const size_t row = m0w + mi * 16 + fr;
        *(uint2*)(dst + row * DM + col) = pack4(0.6065306597126334f * sigmoidf_(acc[mi][ni][0] + bias.x), 0.6065306597126334f * sigmoidf_(acc[mi][ni][1] + bias.y),
                                                0.6065306597126334f * sigmoidf_(acc[mi][ni][2] + bias.z), 0.6065306597126334f * sigmoidf_(acc[mi][ni][3] + bias.w));
      }
    }
  }
};
struct EpiLora2A {
  bf16_t* dst; const float* a0;
  __device__ __forceinline__ void operator()(f32x4 (&acc)[4][4], int m0w, int n0w, int fr, int fq) const {
#pragma unroll
    for (int ni = 0; ni < 4; ni++) {
      const int col = n0w + ni * 16 + fq * 4;
      const float4 bias = *(const float4*)(a0 + col);
#pragma unroll
      for (int mi = 0; mi < 4; mi++) {
        const size_t row = m0w + mi * 16 + fr;
        *(uint2*)(dst + row * DM + col) = pack4(sigmoidf_(acc[mi][ni][0] + bias.x), sigmoidf_(acc[mi][ni][1] + bias.y),
                                                sigmoidf_(acc[mi][ni][2] + bias.z), sigmoidf_(acc[mi][ni][3] + bias.w));
      }
    }
  }
};
struct EpiGPost {
  const bf16_t* Y; const bf16_t* RKV; const float* BONUS;
  const float* ln_g; const float* ln_b;
  bf16_t* dst;
  __device__ __forceinline__ void operator()(f32x4 (&acc)[4][4], int m0w, int n0w, int fr, int fq) const {
#pragma unroll
    for (int mi = 0; mi < 4; mi++) {
      const size_t row = m0w + mi * 16 + fr;
      float yv[2][8], vv[2][8];
      float sy = 0.f;
      const float sb = BONUS[row * 16 + (n0w >> 6)];
#pragma unroll
      for (int pp = 0; pp < 2; pp++) {
        const int col = n0w + pp * 32 + fq * 8;
        const uint4 y4 = *(const uint4*)(Y + row * DM + col);
        const uint4 v4 = *(const uint4*)(RKV + row * 3072 + 2048 + col);
        const unsigned yu[4] = {y4.x, y4.y, y4.z, y4.w};
        const unsigned vu[4] = {v4.x, v4.y, v4.z, v4.w};
#pragma unroll
        for (int q = 0; q < 4; q++) {
#pragma unroll
          for (int hl = 0; hl < 2; hl++) {
            const int e = q * 2 + hl;
            const float yy = hl ? hi_bf(yu[q]) : lo_bf(yu[q]);
            const float vx = hl ? hi_bf(vu[q]) : lo_bf(vu[q]);
            yv[pp][e] = yy; vv[pp][e] = vx;
            sy += yy;
          }
        }
      }
      sy = quad_sum(sy);
      const float mean = sy * (1.0f / 64.0f);
      float sv = 0.f;
#pragma unroll
      for (int pp = 0; pp < 2; pp++)
#pragma unroll
        for (int e = 0; e < 8; e++) { const float d = yv[pp][e] - mean; sv += d * d; }
      sv = quad_sum(sv);
      const float rstd = __builtin_amdgcn_rsqf(sv * (1.0f / 64.0f) + 64e-5f);
#pragma unroll
      for (int pp = 0; pp < 2; pp++) {
        const int col = n0w + pp * 32 + fq * 8;
        const float4 lg0 = *(const float4*)(ln_g + col), lg1 = *(const float4*)(ln_g + col + 4);
        const float4 lb0 = *(const float4*)(ln_b + col), lb1 = *(const float4*)(ln_b + col + 4);
        const float lgc[8] = {lg0.x, lg0.y, lg0.z, lg0.w, lg1.x, lg1.y, lg1.z, lg1.w};
        const float lbc[8] = {lb0.x, lb0.y, lb0.z, lb0.w, lb1.x, lb1.y, lb1.z, lb1.w};
        float o[8];
#pragma unroll
        for (int e = 0; e < 8; e++) {
          const float yn = (yv[pp][e] - mean) * rstd * lgc[e] + lbc[e];
          const float gp = acc[mi][2 * pp + (e >> 2)][e & 3];
          o[e] = (yn + sb * vv[pp][e]) * (gp * sigmoidf_(gp));
        }
        *(uint4*)(dst + row * DM + col) = make_uint4(pack2(o[0], o[1]), pack2(o[2], o[3]), pack2(o[4], o[5]), pack2(o[6], o[7]));
      }
      __builtin_amdgcn_sched_barrier(0);
    }
  }
};
struct EpiResidual {
  const float* res; const float* gate; float* dst;
  __device__ __forceinline__ void operator()(f32x4 (&acc)[4][4], int m0w, int n0w, int fr, int fq) const {
    const int b = m0w >> 11;
    float4 gt[4];
#pragma unroll
    for (int ni = 0; ni < 4; ni++) gt[ni] = *(const float4*)(gate + b * 3072 + n0w + PCOL(ni));
#pragma unroll
    for (int mi = 0; mi < 4; mi++) {
      const size_t row = m0w + mi * 16 + fr;
#pragma unroll
      for (int ni = 0; ni < 4; ni++) {
        const size_t o = row * DM + n0w + PCOL(ni);
        const float4 r = *(const float4*)(res + o);
        float4 w;
        w.x = r.x + gt[ni].x * acc[mi][ni][0];
        w.y = r.y + gt[ni].y * acc[mi][ni][1];
        w.z = r.z + gt[ni].z * acc[mi][ni][2];
        w.w = r.w + gt[ni].w * acc[mi][ni][3];
        *(float4*)(dst + o) = w;
      }
      __builtin_amdgcn_sched_barrier(0);
    }
  }
};
__device__ __forceinline__ void headnorm_rope_store(f32x4 (&acc)[4][4], int m0w, int fr, int fq, bf16_t* dst, int dcol,
                                                    const float* gain, float scale, const float* cs, const float* sn) {
  float gn[4][4];
#pragma unroll
  for (int ni = 0; ni < 4; ni++) {
    const float4 g4 = *(const float4*)(gain + PCOL(ni));
    gn[ni][0] = g4.x; gn[ni][1] = g4.y; gn[ni][2] = g4.z; gn[ni][3] = g4.w;
  }
#pragma unroll
  for (int mi = 0; mi < 4; mi++) {
    const size_t row = m0w + mi * 16 + fr;
    const int pos = (int)(row & 2047);
    float ss = 0.f;
#pragma unroll
    for (int ni = 0; ni < 4; ni++)
#pragma unroll
      for (int j = 0; j < 4; j++) ss += acc[mi][ni][j] * acc[mi][ni][j];
    ss = quad_sum(ss);
    const float rinv = __builtin_amdgcn_rsqf(ss * (1.0f / 64.0f) + 1e-6f) * scale;
    const float4 c0 = *(const float4*)(cs + pos * 32 + fq * 8), s0 = *(const float4*)(sn + pos * 32 + fq * 8);
    const float4 c1 = *(const float4*)(cs + pos * 32 + fq * 8 + 4), s1 = *(const float4*)(sn + pos * 32 + fq * 8 + 4);
    const float cc0[4] = {c0.x, c0.y, c0.z, c0.w}, ss0[4] = {s0.x, s0.y, s0.z, s0.w};
    const float cc1[4] = {c1.x, c1.y, c1.z, c1.w}, ss1[4] = {s1.x, s1.y, s1.z, s1.w};
    float o0[4], o1[4], o2[4], o3[4];
#pragma unroll
    for (int j = 0; j < 4; j++) {
      const float v0 = acc[mi][0][j] * rinv * gn[0][j], v1 = acc[mi][1][j] * rinv * gn[1][j];
      const float v2 = acc[mi][2][j] * rinv * gn[2][j], v3 = acc[mi][3][j] * rinv * gn[3][j];
      o0[j] = v0 * cc0[j] - v2 * ss0[j];
      o2[j] = v2 * cc0[j] + v0 * ss0[j];
      o1[j] = v1 * cc1[j] - v3 * ss1[j];
      o3[j] = v3 * cc1[j] + v1 * ss1[j];
    }
    bf16_t* d = dst + row * DM + dcol + fq * 8;
    {
      const uint2 a = pack4(o0[0], o0[1], o0[2], o0[3]), bq = pack4(o1[0], o1[1], o1[2], o1[3]);
      const uint2 c = pack4(o2[0], o2[1], o2[2], o2[3]), e = pack4(o3[0], o3[1], o3[2], o3[3]);
      *(uint4*)(d) = make_uint4(a.x, a.y, bq.x, bq.y);
      *(uint4*)(d + 32) = make_uint4(c.x, c.y, e.x, e.y);
    }
    __builtin_amdgcn_sched_barrier(0);
  }
}
struct EpiKV {
  bf16_t* KSH; bf16_t* VSH; const float* kg; const float* cs; const float* sn;
  __device__ __forceinline__ void operator()(f32x4 (&acc)[4][4], int m0w, int n0w, int fr, int fq) const {
    if (n0w < 1024) {
      headnorm_rope_store(acc, m0w, fr, fq, KSH, n0w, kg, 1.0f, cs, sn);
    } else {
      EpiStoreBf16 e{VSH, DM, -1024};
      e(acc, m0w, n0w, fr, fq);
    }
  }
};
struct EpiQ {
  bf16_t* Q0; bf16_t* Q1; bf16_t* Q2; const float* qg; const float* cs; const float* sn;
  __device__ __forceinline__ void operator()(f32x4 (&acc)[4][4], int m0w, int n0w, int fr, int fq) const {
    const int g = n0w >> 10;
    bf16_t* Q = (g == 0) ? Q0 : (g == 1) ? Q1 : Q2;
    headnorm_rope_store(acc, m0w, fr, fq, Q, n0w & 1023, qg, 0.18033688011112042f, cs, sn);
  }
};
struct EpiMerge {
  const bf16_t* O0; const bf16_t* O1; const bf16_t* O2; const float2* ML; bf16_t* dst;
  __device__ __forceinline__ void operator()(f32x4 (&acc)[4][4], int m0w, int n0w, int fr, int fq) const {
    const int h = n0w >> 6;
#pragma unroll
    for (int mi = 0; mi < 4; mi++) {
      const size_t row = m0w + mi * 16 + fr;
      const float2 a0 = ML[(0 * (size_t)T_TOK + row) * 16 + h];
      const float2 a1 = ML[(1 * (size_t)T_TOK + row) * 16 + h];
      const float2 a2 = ML[(2 * (size_t)T_TOK + row) * 16 + h];
      const float M = fmaxf(a0.x, fmaxf(a1.x, a2.x));
      const float w0 = __builtin_amdgcn_exp2f(a0.x - M) * a0.y, w1 = __builtin_amdgcn_exp2f(a1.x - M) * a1.y, w2 = __builtin_amdgcn_exp2f(a2.x - M) * a2.y;
      const float inv = __builtin_amdgcn_rcpf(w0 + w1 + w2);
#pragma unroll
      for (int pp = 0; pp < 2; pp++) {
        const size_t o = row * DM + n0w + pp * 32 + fq * 8;
        const uint4 p0 = *(const uint4*)(O0 + o), p1 = *(const uint4*)(O1 + o), p2 = *(const uint4*)(O2 + o);
        const unsigned u0[4] = {p0.x, p0.y, p0.z, p0.w}, u1[4] = {p1.x, p1.y, p1.z, p1.w}, u2[4] = {p2.x, p2.y, p2.z, p2.w};
        unsigned out[4];
#pragma unroll
        for (int q = 0; q < 4; q++) {
          const float lo = (w0 * lo_bf(u0[q]) + w1 * lo_bf(u1[q]) + w2 * lo_bf(u2[q])) * inv;
          const float hi = (w0 * hi_bf(u0[q]) + w1 * hi_bf(u1[q]) + w2 * hi_bf(u2[q])) * inv;
          const float g0 = acc[mi][2 * pp + (q >> 1)][(q & 1) * 2], g1 = acc[mi][2 * pp + (q >> 1)][(q & 1) * 2 + 1];
          out[q] = pack2(lo * g0 * sigmoidf_(g0), hi * g1 * sigmoidf_(g1));
        }
        *(uint4*)(dst + o) = make_uint4(out[0], out[1], out[2], out[3]);
      }
      __builtin_amdgcn_sched_barrier(0);
    }
  }
};

typedef float v2f __attribute__((ext_vector_type(2)));
constexpr int SC_STEP = 384;
constexpr int SC_CH = 16;
__device__ __forceinline__ void phase_scan(const Params& p, unsigned char* lds) {
  float* inbuf = (float*)lds;
  float* ybuf = (float*)(lds + 2 * SC_CH * SC_STEP * 4);
  const int tid = opaque_tid(), lane = tid & 63, wave = tid >> 6;
  unsigned char* ws = p.ws;
  const bf16_t* RKV = (const bf16_t*)(ws + 4 * SLOT);
  const bf16_t* WDEC = (const bf16_t*)(ws + 3 * SLOT);
  const bf16_t* AICL = (const bf16_t*)(ws + 1 * SLOT);
  bf16_t* Y = (bf16_t*)(ws + 2 * SLOT);
  const float* k_k = p.in[13];
  const float* k_a = p.in[14];
  constexpr int NCH = SEQ / SC_CH;
  for (int tile = blockIdx.x; tile < 256; tile += gridDim.x) {
    const int b = tile >> 5, h = (tile >> 1) & 15, half = tile & 1;
    const size_t tok0 = (size_t)b * SEQ;
    if (wave >= 4) {
      const int lw = wave - 4, ss = lane >> 4, eg = lane & 15, e0 = eg * 4;
      const int stp = lw * 4 + ss;
      const float4 kk4 = *(const float4*)(k_k + h * 64 + e0);
      const float4 ka4 = *(const float4*)(k_a + h * 64 + e0);
      const float4 rk4 = *(const float4*)(p.in[15] + h * 64 + e0);
      float* BONUS = (float*)(ws + OFF_SPARE);
      uint2 r0, k0, a0, v0, r1, k1, a1, v1, r2, k2, a2, v2, w0, w1, w2;
      v0 = make_uint2(0, 0); v1 = v0; v2 = v0;
#define SC_GLOAD(S, CH)                                                                         \
      {                                                                                         \
        const size_t tok_ = tok0 + (size_t)(CH) * SC_CH + stp;                                  \
        r##S = *(const uint2*)(RKV + tok_ * 3072 + h * 64 + e0);                                \
        k##S = *(const uint2*)(RKV + tok_ * 3072 + 1024 + h * 64 + e0);                         \
        a##S = *(const uint2*)(AICL + tok_ * DM + h * 64 + e0);                                 \
        w##S = *(const uint2*)(WDEC + tok_ * DM + h * 64 + e0);                                 \
        if (eg < 8) v##S = *(const uint2*)(RKV + tok_ * 3072 + 2048 + h * 64 + half * 32 + eg * 4); \
      }
#define SC_ITER(S, C)                                                                           \
      {                                                                                         \
        const int c_ = (C);                                                                     \
        if (c_ + 1 < NCH) {                                                                     \
          const float r[4] = {lo_bf(r##S.x), hi_bf(r##S.x), lo_bf(r##S.y), hi_bf(r##S.y)};      \
          const float k[4] = {lo_bf(k##S.x), hi_bf(k##S.x), lo_bf(k##S.y), hi_bf(k##S.y)};      \
          const float a[4] = {lo_bf(a##S.x), hi_bf(a##S.x), lo_bf(a##S.y), hi_bf(a##S.y)};      \
          const float w[4] = {__expf(-lo_bf(w##S.x)), __expf(-hi_bf(w##S.x)), __expf(-lo_bf(w##S.y)), __expf(-hi_bf(w##S.y))}; \
          const float kkc[4] = {kk4.x, kk4.y, kk4.z, kk4.w};                                    \
          const float kac[4] = {ka4.x, ka4.y, ka4.z, ka4.w};                                    \
          float kkr[4], km[4];                                                                  \
          float n2 = 0.f;                                                                       \
          _Pragma("unroll") for (int i = 0; i < 4; i++) { kkr[i] = k[i] * kkc[i]; n2 += kkr[i] * kkr[i]; km[i] = k[i] * (1.0f + (a[i] - 1.0f) * kac[i]); } \
          n2 = row16_sum(n2);                                                                   \
          const float inv = __builtin_amdgcn_rsqf(fmaxf(n2, 1e-24f));                                        \
          float an[4], bv[4], wr[4];                                                            \
          float br = 0.f, kr = 0.f;                                                             \
          _Pragma("unroll") for (int i = 0; i < 4; i++) {                                       \
            const float kk = kkr[i] * inv;                                                      \
            an[i] = -kk; bv[i] = kk * a[i]; wr[i] = w[i] * r[i];                                \
            br += bv[i] * r[i]; kr += km[i] * r[i];                                             \
          }                                                                                     \
          float bn = r[0] * km[0] * rk4.x + r[1] * km[1] * rk4.y + r[2] * km[2] * rk4.z + r[3] * km[3] * rk4.w; \
          row16_sum3(br, kr, bn);                                                               \
          if (eg == 0 && half == 0) BONUS[(tok0 + (size_t)(c_ + 1) * SC_CH + stp) * 16 + h] = bn; \
          float* base = inbuf + (((c_ + 1) & 1) * SC_CH + stp) * SC_STEP;                       \
          *(float4*)(base + e0) = make_float4(w[0], w[1], w[2], w[3]);                          \
          *(float4*)(base + 64 + e0) = make_float4(bv[0], bv[1], bv[2], bv[3]);                 \
          *(float4*)(base + 128 + e0) = make_float4(km[0], km[1], km[2], km[3]);                \
          *(float4*)(base + 192 + e0) = make_float4(an[0], an[1], an[2], an[3]);                \
          *(float4*)(base + 256 + e0) = make_float4(wr[0], wr[1], wr[2], wr[3]);                \
          if (eg < 8) {                                                                         \
            *(float4*)(base + 320 + eg * 8) = make_float4(br, kr, lo_bf(v##S.x), hi_bf(v##S.x)); \
            *(float4*)(base + 324 + eg * 8) = make_float4(br, kr, lo_bf(v##S.y), hi_bf(v##S.y)); \
          }                                                                                     \
        }                                                                                       \
        if (c_ + 4 < NCH) SC_GLOAD(S, c_ + 4);                                                  \
        if (c_ >= 1) {                                                                          \
          const int idx = (tid - 256) * 2;                                                      \
          const int st_ = idx >> 5, rr = idx & 31;                                              \
          const float2 yv = *(const float2*)(ybuf + (((c_ + 1) & 1) * SC_CH + st_) * 32 + rr);  \
          *(unsigned*)(Y + (tok0 + (size_t)(c_ - 1) * SC_CH + st_) * DM + h * 64 + half * 32 + rr) = pack2(yv.x, yv.y); \
        }                                                                                       \
        __syncthreads();                                                                        \
      }
      SC_GLOAD(0, 0);
      SC_GLOAD(1, 1);
      SC_GLOAD(2, 2);
      for (int c = -1; c < NCH; c += 3) {
        SC_ITER(0, c);
        SC_ITER(1, c + 1);
        SC_ITER(2, c + 2);
      }
#undef SC_GLOAD
#undef SC_ITER
      {
        const int idx = (tid - 256) * 2;
        const int st = idx >> 5, rr = idx & 31;
        const float2 yv = *(const float2*)(ybuf + (((NCH - 1) & 1) * SC_CH + st) * 32 + rr);
        *(unsigned*)(Y + (tok0 + (size_t)(NCH - 1) * SC_CH + st) * DM + h * 64 + half * 32 + rr) = pack2(yv.x, yv.y);
      }
    } else {
      const int sub = lane & 15, rp = lane >> 4;
      const int rl = wave * 8 + rp * 2;
      v2f st[4];
#pragma unroll
      for (int e = 0; e < 4; e++) st[e] = (v2f){0.f, 0.f};
      for (int c = -1; c < NCH; c++) {
        if (c >= 0) {
          const float* cb = inbuf + ((c & 1) * SC_CH) * SC_STEP;
          float ys0 = 0.f, ys1 = 0.f;
          float4 cw4, cb4, ck4, ca4, cq4, cbv;
          float4 nw4, nb4, nk4, na4, nq4, nbv;
          {
            const float* base = cb;
            cw4 = *(const float4*)(base + sub * 4);
            cb4 = *(const float4*)(base + 64 + sub * 4);
            ck4 = *(const float4*)(base + 128 + sub * 4);
            ca4 = *(const float4*)(base + 192 + sub * 4);
            cq4 = *(const float4*)(base + 256 + sub * 4);
            cbv = *(const float4*)(base + 320 + rl * 2);
          }
#pragma unroll
          for (int s = 0; s < SC_CH; s++) {
            if (s + 1 < SC_CH) {
              const float* base = cb + (s + 1) * SC_STEP;
              nw4 = *(const float4*)(base + sub * 4);
              nb4 = *(const float4*)(base + 64 + sub * 4);
              nk4 = *(const float4*)(base + 128 + sub * 4);
              na4 = *(const float4*)(base + 192 + sub * 4);
              nq4 = *(const float4*)(base + 256 + sub * 4);
              nbv = *(const float4*)(base + 320 + rl * 2);
            }
            __builtin_amdgcn_sched_barrier(0);
            const float wv[4] = {cw4.x, cw4.y, cw4.z, cw4.w};
            const float bv[4] = {cb4.x, cb4.y, cb4.z, cb4.w};
            const float kv[4] = {ck4.x, ck4.y, ck4.z, ck4.w};
            const float av[4] = {ca4.x, ca4.y, ca4.z, ca4.w};
            const float qv[4] = {cq4.x, cq4.y, cq4.z, cq4.w};
            v2f accA = (v2f){0.f, 0.f}, accY = (v2f){0.f, 0.f};
#pragma unroll
            for (int e = 0; e < 4; e++) {
              accA = __builtin_elementwise_fma(st[e], (v2f){av[e], av[e]}, accA);
              accY = __builtin_elementwise_fma(st[e], (v2f){qv[e], qv[e]}, accY);
            }
            float sa0 = accA.x, sa1 = accA.y, sy0 = accY.x, sy1 = accY.y;
            row16_sum4(sa0, sa1, sy0, sy1);
            const v2f sa = (v2f){sa0, sa1};
            const v2f vv = (v2f){cbv.z, cbv.w};
            v2f yy = (v2f){sy0, sy1};
            yy = __builtin_elementwise_fma(sa, (v2f){cbv.x, cbv.x}, yy);
            yy = __builtin_elementwise_fma(vv, (v2f){cbv.y, cbv.y}, yy);
            const float y0 = yy.x, y1 = yy.y;
#pragma unroll
            for (int e = 0; e < 4; e++) {
              v2f t = st[e] * (v2f){wv[e], wv[e]};
              t = __builtin_elementwise_fma(sa, (v2f){bv[e], bv[e]}, t);
              st[e] = __builtin_elementwise_fma(vv, (v2f){kv[e], kv[e]}, t);
            }
            ys0 = (s == sub) ? y0 : ys0;
            ys1 = (s == sub) ? y1 : ys1;
            cw4 = nw4; cb4 = nb4; ck4 = nk4; ca4 = na4; cq4 = nq4; cbv = nbv;
          }
          *(float2*)(ybuf + ((c & 1) * SC_CH + sub) * 32 + rl) = make_float2(ys0, ys1);
        }
        __syncthreads();
      }
    }
    __syncthreads();
  }
}

__device__ __forceinline__ void phase_norm2(const Params& p) {
  const int tid_ = opaque_tid(); const int lane = tid_ & 63, wave = tid_ >> 6;
  unsigned char* ws = p.ws;
  const float* X1 = (const float*)(ws + 2 * SLOT);
  const float* kvg = p.in[19];
  const float* bg = p.in[24];
  const float* modB = (const float*)(ws + OFF_MODB);
  bf16_t* A1 = (bf16_t*)(ws + 4 * SLOT);
  bf16_t* A2 = (bf16_t*)(ws + 5 * SLOT);
  for (int u = blockIdx.x; u < T_TOK / 8; u += gridDim.x) {
    const int t = u * 8 + wave;
    const int b = t >> 11;
    const float4* xr = (const float4*)(X1 + (size_t)t * DM);
    float4 cur[4];
    float ss = 0.f;
#pragma unroll
    for (int i = 0; i < 4; i++) {
      cur[i] = xr[(i >> 1) * 128 + lane * 2 + (i & 1)];
      ss += cur[i].x * cur[i].x + cur[i].y * cur[i].y + cur[i].z * cur[i].z + cur[i].w * cur[i].w;
    }
    ss = wave_sum(ss);
    const float rinv = __builtin_amdgcn_rsqf(ss * (1.0f / 1024.0f) + 1e-6f);
#pragma unroll
    for (int jp = 0; jp < 2; jp++) {
      const int d = jp * 512 + lane * 8;
      unsigned o1[4], o2[4];
#pragma unroll
      for (int hf = 0; hf < 2; hf++) {
        const int i = jp * 2 + hf;
        const float4 g1 = *(const float4*)(kvg + d + hf * 4);
        const float4 g2 = *(const float4*)(bg + d + hf * 4);
        const float4 sh = *(const float4*)(modB + b * 3072 + d + hf * 4);
        const float4 sc = *(const float4*)(modB + b * 3072 + 1024 + d + hf * 4);
        const float n0 = cur[i].x * rinv, n1 = cur[i].y * rinv, n2 = cur[i].z * rinv, n3 = cur[i].w * rinv;
        o1[hf * 2] = pack2(n0 * g1.x, n1 * g1.y); o1[hf * 2 + 1] = pack2(n2 * g1.z, n3 * g1.w);
        o2[hf * 2] = pack2(n0 * g2.x * (1.f + sc.x) + sh.x, n1 * g2.y * (1.f + sc.y) + sh.y);
        o2[hf * 2 + 1] = pack2(n2 * g2.z * (1.f + sc.z) + sh.z, n3 * g2.w * (1.f + sc.w) + sh.w);
      }
      const size_t o = (size_t)t * DM + d;
      *(uint4*)(A1 + o) = make_uint4(o1[0], o1[1], o1[2], o1[3]);
      *(uint4*)(A2 + o) = make_uint4(o2[0], o2[1], o2[2], o2[3]);
    }
  }
}

typedef __attribute__((ext_vector_type(4))) short s16x4;
typedef __attribute__((address_space(3))) s16x4 lds_s16x4;
__device__ __forceinline__ void phase_attn(const Params& p, unsigned char* lds) {
  bf16_t* Ks = (bf16_t*)lds;
  bf16_t* Vs = (bf16_t*)(lds + 256 * 144);
  const int tid = opaque_tid(), lane = tid & 63, wave = tid >> 6;
  const int c16 = lane & 15, quad = lane >> 4;
  unsigned char* ws = p.ws;
  const bf16_t* KSH = (const bf16_t*)(ws + 6 * SLOT);
  const bf16_t* VSH = (const bf16_t*)(ws + 7 * SLOT);
  bf16_t* Q0 = (bf16_t*)p.out;
  bf16_t* Q1 = (bf16_t*)((unsigned char*)p.out + SLOT);
  bf16_t* Q2 = (bf16_t*)(ws + 1 * SLOT);
  float2* ML = (float2*)(ws + OFF_SPARE);
  uint4 kreg[4], vreg[4];
  bf16x8 qreg0, qreg1;
  auto issue = [&](int tile) {
    const int g = tile >> 11, rem = tile & 2047;
    const int b = rem >> 8, h = (rem >> 4) & 15, jj = rem & 15;
    const int dsh = g * 2, dil = 1 << dsh;
    const int r = jj & (dil - 1), n = jj >> dsh;
    const size_t tokb = (size_t)b * SEQ;
    {
      const bf16_t* Qn = (g == 0) ? Q0 : (g == 1) ? Q1 : Q2;
      const size_t qo = (tokb + (size_t)((n * 128 + wave * 16 + c16) * dil + r)) * DM + h * 64;
      qreg0 = *(const bf16x8*)(Qn + qo + quad * 8);
      qreg1 = *(const bf16x8*)(Qn + qo + 32 + quad * 8);
    }
#pragma unroll
    for (int i = 0; i < 4; i++) {
      const int c = tid + i * 512;
      const int kl = c >> 3, ec = (c & 7) * 8;
      const int lp = (n - 1) * 128 + kl;
      kreg[i] = make_uint4(0, 0, 0, 0);
      vreg[i] = make_uint4(0, 0, 0, 0);
      if (lp >= 0) {
        const size_t off = (tokb + (size_t)(lp * dil + r)) * DM + h * 64 + ec;
        kreg[i] = *(const uint4*)(KSH + off);
        vreg[i] = *(const uint4*)(VSH + off);
      }
    }
  };
  int tile = blockIdx.x;
  if (tile < 6144) issue(tile);
  for (; tile < 6144; tile += gridDim.x) {
    const int g = tile >> 11, rem = tile & 2047;
    const int b = rem >> 8, h = (rem >> 4) & 15, jj = rem & 15;
    const int dsh = g * 2, dil = 1 << dsh;
    const int r = jj & (dil - 1), n = jj >> dsh;
    bf16_t* Qg = (g == 0) ? Q0 : (g == 1) ? Q1 : Q2;
    const size_t tokb = (size_t)b * SEQ;
#pragma unroll
    for (int i = 0; i < 4; i++) {
      const int c = tid + i * 512;
      const int kl = c >> 3, ec = (c & 7) * 8;
      *(uint4*)(Ks + kl * 72 + ec) = kreg[i];
      *(uint4*)(Vs + kl * 72 + ec) = vreg[i];
    }
    const bf16x8 qf0 = qreg0, qf1 = qreg1;
    __syncthreads();
    if (tile + (int)gridDim.x < 6144) issue(tile + gridDim.x);
    __builtin_amdgcn_sched_barrier(0);
    const int lq = n * 128 + wave * 16 + c16;
    const int posq = lq * dil + r;
    const size_t qoff = (tokb + posq) * DM + h * 64;
    f32x4 sc[9];
#pragma unroll
    for (int t = 0; t < 9; t++) {
      const bf16_t* krow = Ks + ((wave + t) * 16 + c16) * 72 + quad * 8;
      const bf16x8 a0 = *(const bf16x8*)krow;
      const bf16x8 a1 = *(const bf16x8*)(krow + 32);
      f32x4 sv = (f32x4){0.f, 0.f, 0.f, 0.f};
      sv = __builtin_amdgcn_mfma_f32_16x16x32_bf16(a0, qf0, sv, 0, 0, 0);
      sv = __builtin_amdgcn_mfma_f32_16x16x32_bf16(a1, qf1, sv, 0, 0, 0);
      sc[t] = sv;
    }
    __builtin_amdgcn_sched_barrier(0);
    float m = -1e30f;
    const int dm = c16 - quad * 4;
#pragma unroll
    for (int t = 0; t < 9; t++) {
      const bool tile_ok = (n > 0) || (wave + t >= 8);
#pragma unroll
      for (int j = 0; j < 4; j++) {
        bool valid = tile_ok;
        if (t == 0) valid = valid && (dm <= j);
        if (t == 8) valid = valid && (dm >= j);
        const float v = valid ? sc[t][j] : -1e30f;
        sc[t][j] = v;
        m = fmaxf(m, v);
      }
    }
    m = fmaxf(m, __shfl_xor(m, 16));
    m = fmaxf(m, __shfl_xor(m, 32));
    float l = 0.f;
#pragma unroll
    for (int t = 0; t < 9; t++)
#pragma unroll
      for (int j = 0; j < 4; j++) {
        const float pv = __builtin_amdgcn_exp2f(sc[t][j] - m);
        sc[t][j] = pv;
        l += pv;
      }
    l += __shfl_xor(l, 16);
    l += __shfl_xor(l, 32);
    __builtin_amdgcn_sched_barrier(0);
    f32x4 o[4];
#pragma unroll
    for (int ct = 0; ct < 4; ct++) o[ct] = (f32x4){0.f, 0.f, 0.f, 0.f};
    const int tq = c16 >> 2, tp = c16 & 3;
#pragma unroll
    for (int pr = 0; pr < 5; pr++) {
      const int ta = 2 * pr;
      const int tb = (pr < 4) ? (2 * pr + 1) : ta;
      union { bf16x8 v; unsigned u[4]; } pf;
      pf.u[0] = pack2(sc[ta][0], sc[ta][1]);
      pf.u[1] = pack2(sc[ta][2], sc[ta][3]);
      if (pr < 4) {
        pf.u[2] = pack2(sc[tb][0], sc[tb][1]);
        pf.u[3] = pack2(sc[tb][2], sc[tb][3]);
      } else {
        pf.u[2] = 0; pf.u[3] = 0;
      }
      __builtin_amdgcn_sched_barrier(0);
      const bf16_t* va = Vs + ((wave + ta) * 16 + quad * 4 + tq) * 72 + 8 * tp;
      const bf16_t* vb = Vs + ((wave + tb) * 16 + quad * 4 + tq) * 72 + 8 * tp;
#pragma unroll
      for (int ct = 0; ct < 4; ct++) {
        union { bf16x8 v; s16x4 h[2]; } vf;
        vf.h[0] = __builtin_amdgcn_ds_read_tr16_b64_v4i16((lds_s16x4*)(va + (ct >> 1) * 32 + (ct & 1) * 4));
        vf.h[1] = __builtin_amdgcn_ds_read_tr16_b64_v4i16((lds_s16x4*)(vb + (ct >> 1) * 32 + (ct & 1) * 4));
        o[ct] = __builtin_amdgcn_mfma_f32_16x16x32_bf16(vf.v, pf.v, o[ct], 0, 0, 0);
      }
    }
    __builtin_amdgcn_sched_barrier(0);
    const float inv = __builtin_amdgcn_rcpf(l);
#pragma unroll
    for (int pp = 0; pp < 2; pp++) {
      const uint2 lo = pack4(o[2 * pp][0] * inv, o[2 * pp][1] * inv, o[2 * pp][2] * inv, o[2 * pp][3] * inv);
      const uint2 hi = pack4(o[2 * pp + 1][0] * inv, o[2 * pp + 1][1] * inv, o[2 * pp + 1][2] * inv, o[2 * pp + 1][3] * inv);
      *(uint4*)(Qg + qoff + pp * 32 + quad * 8) = make_uint4(lo.x, lo.y, hi.x, hi.y);
    }
    if (quad == 0) ML[((size_t)g * T_TOK + tokb + posq) * 16 + h] = make_float2(m, l);
    __syncthreads();
  }
}

template <int ph>
__device__ __forceinline__ void run_phase(const Params& p, unsigned char* lds) {
  unsigned char* ws = p.ws;
  unsigned char* dob = (unsigned char*)p.out;
  const float* cs = (const float*)(ws + OFF_ROPE);
  const float* sn = cs + 65536;
  switch (ph) {
    case 0: phase_prep(p, lds, 0, 192); break;
    case 1: phase_mix(p); phase_prep(p, lds, 192, 512 + 3168); break;
    case 2: {
      const bf16_t* XS[4] = {(const bf16_t*)dob, (const bf16_t*)(dob + SLOT), (const bf16_t*)(ws + 2 * SLOT), (const bf16_t*)(ws + 7 * SLOT)};
      unsigned* flags = (unsigned*)(ws + OFF_PANEL);
      const bf16_t* LO1 = (const bf16_t*)(ws + OFF_SPARE);
      const bool merged = (gridDim.x == 256);
      auto big_tile = [&](int idx) __attribute__((always_inline)) {
        const int li = idx >> 3;
        const int m = (idx & 7) * 8 + (li & 7), n = li >> 3;
        const int pp = n >> 2;
        const bf16_t* A = (pp == 0) ? XS[0] : (pp == 1) ? XS[1] : XS[2];
        GemmArgs g{A, A, 1024, 1024, (const bf16_t*)(ws + OFF_WT_AIN), 1024, 1024};
        EpiStoreBf16 e{(bf16_t*)(ws + 4 * SLOT), 3072, 0};
        gemm_tile256(g, m * 256, n * 256, lds, e);
      };
      auto lora1_tile = [&](int m) __attribute__((always_inline)) {
        GemmArgs g{(const bf16_t*)dob, (const bf16_t*)(ws + 3 * SLOT), 1024, 1024, (const bf16_t*)(ws + OFF_WT_LORA1), 2048, 2048};
        EpiLora1 e{(bf16_t*)(ws + OFF_SPARE)};
        gemm_tile(g, m * 256, 0, lds, e);
      };
      auto lora2_tile = [&](int sidx) __attribute__((always_inline)) {
        const int m = sidx >> 4, n = sidx & 15;
        if (n < 8) {
          GemmArgs g{LO1, LO1, 64, 128, (const bf16_t*)(ws + OFF_WT_W2), 64, 64};
          EpiLora2W e{(bf16_t*)(ws + 3 * SLOT), p.in[7]};
          gemm_tile(g, m * 256, n * 128, lds, e);
        } else {
          GemmArgs g{LO1 + 64, LO1 + 64, 64, 128, (const bf16_t*)(ws + OFF_WT_A2), 64, 64};
          EpiLora2A e{(bf16_t*)(ws + 1 * SLOT), p.in[10]};
          gemm_tile(g, m * 256, (n - 8) * 128, lds, e);
        }
      };
      if (merged) {
        const int v = blockIdx.x;
        if (v < 64) {
          lora1_tile(v);
          asm volatile("s_waitcnt vmcnt(0)" ::: "memory");
          __syncthreads();
          if (threadIdx.x == 0) {
            __builtin_amdgcn_fence(__ATOMIC_RELEASE, "agent");
            asm volatile("s_waitcnt vmcnt(0)" ::: "memory");
            __hip_atomic_store(flags + v, 1u, __ATOMIC_RELAXED, __HIP_MEMORY_SCOPE_AGENT);
          }
        }
        for (int k = 0; k < 3; k++) big_tile(v + 256 * k);
        const int ns = (v < 64) ? 1 : 5;
        const int s0 = (v < 64) ? v : 64 + (v - 64) * 5;
        int have = -1;
        for (int j = 0; j < ns; j++) {
          const int sidx = s0 + j, m = sidx >> 4;
          if (m != have) {
            if (threadIdx.x < 64) {
              unsigned spins = 0;
              while ((unsigned)__builtin_amdgcn_readfirstlane(__hip_atomic_load(flags + m, __ATOMIC_RELAXED, __HIP_MEMORY_SCOPE_AGENT)) != 1u) {
                __builtin_amdgcn_s_sleep(2);
                if (++spins > (1u << 22)) break;
              }
              __builtin_amdgcn_fence(__ATOMIC_ACQUIRE, "agent");
              asm volatile("s_waitcnt vmcnt(0)" ::: "memory");
            }
            __syncthreads();
            have = m;
          }
          lora2_tile(sidx);
        }
      } else {
        for (int idx = blockIdx.x; idx < 768 + 64; idx += gridDim.x) {
          if (idx < 768) big_tile(idx); else lora1_tile(idx - 768);
        }
      }
    } break;
    case 3: {
      if (gridDim.x != 256) {
        const bf16_t* LO1 = (const bf16_t*)(ws + OFF_SPARE);
        for (int idx = blockIdx.x; idx < 64 * 16; idx += gridDim.x) {
          const int m = idx >> 4, n = idx & 15;
          if (n < 8) {
            GemmArgs g{LO1, LO1, 64, 128, (const bf16_t*)(ws + OFF_WT_W2), 64, 64};
            EpiLora2W e{(bf16_t*)(ws + 3 * SLOT), p.in[7]};
            gemm_tile(g, m * 256, n * 128, lds, e);
          } else {
            GemmArgs g{LO1 + 64, LO1 + 64, 64, 128, (const bf16_t*)(ws + OFF_WT_A2), 64, 64};
            EpiLora2A e{(bf16_t*)(ws + 1 * SLOT), p.in[10]};
            gemm_tile(g, m * 256, (n - 8) * 128, lds, e);
          }
        }
      }
    } break;
    case 4: phase_scan(p, lds); break;
    case 5: {
      for (int idx = blockIdx.x; idx < 64 * 4; idx += gridDim.x) {
        const int m = (idx & 7) * 8 + (idx >> 5), n = (idx >> 3) & 3;
        const bf16_t* XS3 = (const bf16_t*)(ws + 7 * SLOT);
        GemmArgs g{XS3, XS3, 1024, 1024, (const bf16_t*)(ws + OFF_WT_AIN) + (size_t)3072 * 1024, 1024, 1024};
        EpiGPost e{(const bf16_t*)(ws + 2 * SLOT), (const bf16_t*)(ws + 4 * SLOT), (const float*)(ws + OFF_SPARE),
                   p.in[16], p.in[17], (bf16_t*)dob};
        gemm_tile256(g, m * 256, n * 256, lds, e);
      }
    } break;
    case 6: {
      for (int idx = blockIdx.x; idx < 64 * 4; idx += gridDim.x) {
        const int m = (idx & 7) * 8 + (idx >> 5), n = (idx >> 3) & 3;
        const bf16_t* A4 = (const bf16_t*)dob;
        GemmArgs g{A4, A4, 1024, 1024, (const bf16_t*)(ws + OFF_WT_AOUT), 1024, 1024};
        EpiResidual e{p.in[0], (const float*)(ws + OFF_MODA) + 2048, (float*)(ws + 2 * SLOT)};
        gemm_tile256(g, m * 256, n * 256, lds, e);
      }
    } break;
    case 7: phase_norm2(p); break;
    case 8: {
      for (int idx = blockIdx.x; idx < 64 * 20; idx += gridDim.x) {
        const int li = idx >> 3;
        const int m = (idx & 7) * 8 + (li & 7), n = li >> 3;
        if (n < 8) {
          const bf16_t* A1 = (const bf16_t*)(ws + 4 * SLOT);
          GemmArgs g{A1, A1, 1024, 1024, (const bf16_t*)(ws + OFF_WT_KV), 1024, 1024};
          EpiKV e{(bf16_t*)(ws + 6 * SLOT), (bf16_t*)(ws + 7 * SLOT), p.in[21], cs, sn};
          gemm_tile256(g, m * 256, n * 256, lds, e);
        } else {
          const bf16_t* A2 = (const bf16_t*)(ws + 5 * SLOT);
          GemmArgs g{A2, A2, 1024, 1024, (const bf16_t*)(ws + OFF_WT_BIN), 1024, 1024};
          EpiQ e{(bf16_t*)dob, (bf16_t*)(dob + SLOT), (bf16_t*)(ws + 1 * SLOT), p.in[26], cs, sn};
          gemm_tile256(g, m * 256, (n - 8) * 256, lds, e);
        }
      }
    } break;
    case 9: phase_attn(p, lds); break;
    case 10: {
      for (int idx = blockIdx.x; idx < 64 * 4; idx += gridDim.x) {
        const int m = (idx & 7) * 8 + (idx >> 5), n = (idx >> 3) & 3;
        const bf16_t* A2 = (const bf16_t*)(ws + 5 * SLOT);
        GemmArgs g{A2, A2, 1024, 1024, (const bf16_t*)(ws + OFF_WT_BIN) + (size_t)3072 * 1024, 1024, 1024};
        EpiMerge e{(const bf16_t*)dob, (const bf16_t*)(dob + SLOT), (const bf16_t*)(ws + 1 * SLOT), (const float2*)(ws + OFF_SPARE), (bf16_t*)(ws + 4 * SLOT)};
        gemm_tile256(g, m * 256, n * 256, lds, e);
      }
    } break;
    case 11: {
      for (int idx = blockIdx.x; idx < 64 * 4; idx += gridDim.x) {
        const int m = (idx & 7) * 8 + (idx >> 5), n = (idx >> 3) & 3;
        const bf16_t* A7 = (const bf16_t*)(ws + 4 * SLOT);
        GemmArgs g{A7, A7, 1024, 1024, (const bf16_t*)(ws + OFF_WT_BOUT), 1024, 1024};
        EpiResidual e{(const float*)(ws + 2 * SLOT), (const float*)(ws + OFF_MODB) + 2048, p.out};
        gemm_tile256(g, m * 256, n * 256, lds, e);
      }
    } break;
    default: break;
  }
}

template <int PH>
__global__ void __launch_bounds__(NTHREADS) phase_kernel(Params p) {
  extern __shared__ __attribute__((aligned(16))) unsigned char lds[];
  run_phase<PH>(p, lds);
}

__global__ void __launch_bounds__(NTHREADS) mega_kernel(Params p) {
  extern __shared__ __attribute__((aligned(16))) unsigned char lds[];
  cg::grid_group grid = cg::this_grid();
  if (p.ws == nullptr) grid.sync();
  volatile LAS unsigned* xst = (volatile LAS unsigned*)(lds + LDS_BYTES - 16);
  if (threadIdx.x == 0) { xst[0] = 0u; xst[1] = 0u; xst[2] = 0u; xst[3] = 0u; }
  __syncthreads();
  const XcdBarrier xb = xcd_barrier_post((unsigned*)(p.ws + OFF_BAR), xst);
  run_phase<0>(p, lds); xcd_barrier(xb);
  if (PROBE_DOUBLE == 0) { run_phase<0>(p, lds); xcd_barrier(xb); }
  run_phase<1>(p, lds); xcd_barrier(xb);
  if (PROBE_DOUBLE == 1) { run_phase<1>(p, lds); xcd_barrier(xb); }
  run_phase<2>(p, lds);
  if (gridDim.x != 256) xcd_barrier(xb);
  if (PROBE_DOUBLE == 2) { run_phase<2>(p, lds); xcd_barrier(xb); }
  run_phase<3>(p, lds); xcd_barrier(xb);
  if (PROBE_DOUBLE == 3) { run_phase<3>(p, lds); xcd_barrier(xb); }
  run_phase<4>(p, lds); xcd_barrier(xb);
  if (PROBE_DOUBLE == 4) { run_phase<4>(p, lds); xcd_barrier(xb); }
  run_phase<5>(p, lds); xcd_barrier(xb);
  if (PROBE_DOUBLE == 5) { run_phase<5>(p, lds); xcd_barrier(xb); }
  run_phase<6>(p, lds); xcd_barrier(xb);
  if (PROBE_DOUBLE == 6) { run_phase<6>(p, lds); xcd_barrier(xb); }
  run_phase<7>(p, lds); xcd_barrier(xb);
  if (PROBE_DOUBLE == 7) { run_phase<7>(p, lds); xcd_barrier(xb); }
  run_phase<8>(p, lds); xcd_barrier(xb);
  if (PROBE_DOUBLE == 8) { run_phase<8>(p, lds); xcd_barrier(xb); }
  run_phase<9>(p, lds); xcd_barrier(xb);
  if (PROBE_DOUBLE == 89) { run_phase<8>(p, lds); xcd_barrier(xb); run_phase<9>(p, lds); xcd_barrier(xb); }
  run_phase<10>(p, lds); xcd_barrier(xb);
  if (PROBE_DOUBLE == 10) { run_phase<10>(p, lds); xcd_barrier(xb); }
  run_phase<11>(p, lds);
}

template <int PH>
static void launch_phase(const Params& p, int grid, hipStream_t stream) {
  static bool attr = false;
  if (!attr) { (void)hipFuncSetAttribute((const void*)phase_kernel<PH>, hipFuncAttributeMaxDynamicSharedMemorySize, LDS_BYTES); attr = true; }
  hipLaunchKernelGGL(phase_kernel<PH>, dim3(grid), dim3(NTHREADS), LDS_BYTES, stream, p);
}

extern "C" void kernel_launch(void* const* d_in, const int* in_sizes, int n_in, void* d_out, int out_size, void* d_ws,
                              size_t ws_size, hipStream_t stream) {
  static int grid = 0;
  if (grid == 0) {
    int dev = 0, cus = 0;
    if (n_in != 28 || out_size != T_TOK * DM || ws_size < 256 * MiB) {
      fprintf(stderr, "kernel_launch: unexpected shapes n_in=%d out=%d ws=%zu\n", n_in, out_size, ws_size);
      grid = -1;
      return;
    }
    (void)hipGetDevice(&dev);
    (void)hipDeviceGetAttribute(&cus, hipDeviceAttributeMultiprocessorCount, dev);
    (void)hipFuncSetAttribute((const void*)mega_kernel, hipFuncAttributeMaxDynamicSharedMemorySize, LDS_BYTES);
    int per_cu = 0;
    (void)hipOccupancyMaxActiveBlocksPerMultiprocessor(&per_cu, (const void*)mega_kernel, NTHREADS, LDS_BYTES);
    if (per_cu < 1) fprintf(stderr, "kernel_launch: occupancy query says %d blocks/CU\n", per_cu);
    (void)hipGetLastError();
    grid = cus > 0 ? cus : 256;
  }
  if (grid < 0) return;
  Params p{};
  for (int i = 0; i < 28; i++) p.in[i] = (const float*)d_in[i];
  p.out = (float*)d_out;
  p.ws = (unsigned char*)d_ws;
#if ONE_LAUNCH
  (void)hipMemsetAsync((unsigned char*)d_ws + OFF_BAR, 0, 16384, stream);
  void* args[] = {&p};
  hipError_t e = hipLaunchCooperativeKernel((const void*)mega_kernel, dim3(grid), dim3(NTHREADS), args, LDS_BYTES, stream);
  if (e != hipSuccess) fprintf(stderr, "cooperative launch failed: %s (grid %d)\n", hipGetErrorString(e), grid);
#else
  launch_phase<0>(p, grid, stream); launch_phase<1>(p, grid, stream); launch_phase<2>(p, grid, stream);
  launch_phase<3>(p, grid, stream); launch_phase<4>(p, grid, stream); launch_phase<5>(p, grid, stream);
  launch_phase<6>(p, grid, stream); launch_phase<7>(p, grid, stream); launch_phase<8>(p, grid, stream);
  launch_phase<9>(p, grid, stream); launch_phase<10>(p, grid, stream); launch_phase<11>(p, grid, stream);
#endif
}
```

```cpp
#include <hip/hip_runtime.h>
#include <hip/hip_cooperative_groups.h>
#include <cstdio>
#include <cstdint>
namespace cg = cooperative_groups;

#ifndef PROBE_DOUBLE
#define PROBE_DOUBLE -1
#endif
#ifndef ONE_LAUNCH
#define ONE_LAUNCH 1
#endif

typedef __attribute__((ext_vector_type(8))) short bf16x8;
typedef __attribute__((ext_vector_type(4))) float f32x4;
typedef unsigned short bf16_t;

constexpr int T_TOK = 16384;
constexpr int DM = 1024;
constexpr int SEQ = 2048;
constexpr int NTHREADS = 512;
constexpr int LDS_BYTES = 131072 + 16;
constexpr int N_PHASES = 12;

constexpr size_t MiB = 1ull << 20;
constexpr size_t OFF_WT_AIN = 0;
constexpr size_t OFF_WT_LORA1 = OFF_WT_AIN + 8 * MiB;
constexpr size_t OFF_WT_W2 = OFF_WT_LORA1 + 512 * 1024;
constexpr size_t OFF_WT_A2 = OFF_WT_W2 + 128 * 1024;
constexpr size_t OFF_WT_AOUT = OFF_WT_A2 + 128 * 1024;
constexpr size_t OFF_WT_KV = OFF_WT_AOUT + 2 * MiB;
constexpr size_t OFF_WT_BIN = OFF_WT_KV + 4 * MiB;
constexpr size_t OFF_WT_BOUT = OFF_WT_BIN + 8 * MiB;
constexpr size_t OFF_MODA = OFF_WT_BOUT + 2 * MiB;
constexpr size_t OFF_MODB = OFF_MODA + 96 * 1024;
constexpr size_t OFF_ROPE = OFF_MODB + 96 * 1024;
constexpr size_t OFF_SPARE = OFF_ROPE + 512 * 1024;
static_assert(OFF_SPARE + 6 * MiB <= 32 * MiB, "slot0 overflow");
constexpr size_t SLOT = 32 * MiB;

struct Params {
  const float* in[28];
  float* out;
  unsigned char* ws;
};

__device__ __forceinline__ float bf2f(unsigned short b) { return __uint_as_float(((unsigned)b) << 16); }
__device__ __forceinline__ unsigned short f2bf(float f) {
  unsigned u = __float_as_uint(f);
  u += 0x7FFFu + ((u >> 16) & 1u);
  return (unsigned short)(u >> 16);
}
typedef __bf16 bf16x2_t __attribute__((ext_vector_type(2)));
typedef float f32x2_t __attribute__((ext_vector_type(2)));
__device__ __forceinline__ unsigned pack2(float a, float b) {
  const f32x2_t f = {a, b};
  return __builtin_bit_cast(unsigned, __builtin_convertvector(f, bf16x2_t));
}
__device__ __forceinline__ float lo_bf(unsigned u) { return __uint_as_float(u << 16); }
__device__ __forceinline__ float hi_bf(unsigned u) { return __uint_as_float(u & 0xFFFF0000u); }

template <int CTRL>
__device__ __forceinline__ float dpp_f(float v) {
  return __builtin_bit_cast(float, __builtin_amdgcn_update_dpp(0, __builtin_bit_cast(int, v), CTRL, 0xF, 0xF, false));
}
#define DPP_ADD(r, ctl) "v_add_f32_dpp " r ", " r ", " r " " ctl " row_mask:0xf bank_mask:0xf\n\t"
__device__ __forceinline__ float row16_sum(float v) {
  asm("s_nop 1\n\t" DPP_ADD("%0", "quad_perm:[1,0,3,2]") "s_nop 1\n\t" DPP_ADD("%0", "quad_perm:[2,3,0,1]") "s_nop 1\n\t"
      DPP_ADD("%0", "row_half_mirror") "s_nop 1\n\t" DPP_ADD("%0", "row_mirror")
      : "+v"(v));
  return v;
}
__device__ __forceinline__ void row16_sum3(float& a, float& b, float& c) {
  asm("s_nop 1\n\t"
      DPP_ADD("%0", "quad_perm:[1,0,3,2]") DPP_ADD("%1", "quad_perm:[1,0,3,2]") DPP_ADD("%2", "quad_perm:[1,0,3,2]")
      DPP_ADD("%0", "quad_perm:[2,3,0,1]") DPP_ADD("%1", "quad_perm:[2,3,0,1]") DPP_ADD("%2", "quad_perm:[2,3,0,1]")
      DPP_ADD("%0", "row_half_mirror") DPP_ADD("%1", "row_half_mirror") DPP_ADD("%2", "row_half_mirror")
      DPP_ADD("%0", "row_mirror") DPP_ADD("%1", "row_mirror") DPP_ADD("%2", "row_mirror")
      : "+v"(a), "+v"(b), "+v"(c));
}
__device__ __forceinline__ void row16_sum4(float& a, float& b, float& c, float& d) {
  asm("s_nop 1\n\t"
      DPP_ADD("%0", "quad_perm:[1,0,3,2]") DPP_ADD("%1", "quad_perm:[1,0,3,2]") DPP_ADD("%2", "quad_perm:[1,0,3,2]") DPP_ADD("%3", "quad_perm:[1,0,3,2]")
      DPP_ADD("%0", "quad_perm:[2,3,0,1]") DPP_ADD("%1", "quad_perm:[2,3,0,1]") DPP_ADD("%2", "quad_perm:[2,3,0,1]") DPP_ADD("%3", "quad_perm:[2,3,0,1]")
      DPP_ADD("%0", "row_half_mirror") DPP_ADD("%1", "row_half_mirror") DPP_ADD("%2", "row_half_mirror") DPP_ADD("%3", "row_half_mirror")
      DPP_ADD("%0", "row_mirror") DPP_ADD("%1", "row_mirror") DPP_ADD("%2", "row_mirror") DPP_ADD("%3", "row_mirror")
      : "+v"(a), "+v"(b), "+v"(c), "+v"(d));
}
__device__ __forceinline__ float wave_sum(float v) {
#pragma unroll
  for (int o = 32; o >= 1; o >>= 1) v += __shfl_xor(v, o);
  return v;
}
__device__ __forceinline__ int opaque_tid() { int t = threadIdx.x; asm volatile("" : "+v"(t)); return t; }
__device__ __forceinline__ float sigmoidf_(float x) { return __builtin_amdgcn_rcpf(1.0f + __expf(-x)); }

#define XB_TMO      128
#define XB_XCNT(j)  (256  + 64 * (j))
#define XB_XSUB(j)  (1280 + 64 * (j))
#define XB_XGEN(j)  (2304 + 64 * (j))
#define XB_TOP      3328
#define XB_TOPGEN   3392
#define XCD_BAR_WORDS 3456
#define XB_SPIN_CAP (1u << 20)
#define LAS __attribute__((address_space(3)))
constexpr size_t OFF_BAR = SLOT - 16384;
constexpr size_t OFF_PANEL = OFF_BAR + 14336;
static_assert(XCD_BAR_WORDS * 4 <= 16384, "barrier words");
__device__ __forceinline__ unsigned xb_ld(unsigned* p) { return __hip_atomic_load(p, __ATOMIC_RELAXED, __HIP_MEMORY_SCOPE_AGENT); }
__device__ __forceinline__ unsigned xb_add(unsigned* p, unsigned v) { return __hip_atomic_fetch_add(p, v, __ATOMIC_RELAXED, __HIP_MEMORY_SCOPE_AGENT); }
__device__ __forceinline__ unsigned xb_xcc_id() { return (unsigned)__builtin_amdgcn_s_getreg((3 << 11) | 20) & 0xFu; }
#define XB_SPIN(cond, bar) do { unsigned _sp = 0; while (cond) { __builtin_amdgcn_s_sleep(1); \
    if ((++_sp & 255u) == 0u) { if (xb_ld(&(bar)[XB_TMO])) break; if (_sp > XB_SPIN_CAP) { atomicAdd(&(bar)[XB_TMO], 1u); break; } } } } while (0)
struct XcdBarrier { unsigned* bar; unsigned x; volatile LAS unsigned* st; };
__device__ __forceinline__ XcdBarrier xcd_barrier_post(unsigned* bar, volatile LAS unsigned* st) {
  XcdBarrier b; b.bar = bar; b.x = xb_xcc_id(); b.st = st;
  if (threadIdx.x == 0) (void)xb_add(&bar[XB_XCNT(b.x)], 1u);
  return b;
}
__device__ __forceinline__ void xcd_barrier_complete(unsigned* bar, unsigned x, unsigned& nloc, unsigned& nx) {
  const unsigned G = gridDim.x * gridDim.y * gridDim.z;
  unsigned sum, cnt, mine, sp = 0u;
  for (;;) {
    sum = 0u; cnt = 0u; mine = 0u;
#pragma unroll
    for (unsigned j = 0; j < 16; ++j) { const unsigned c = xb_ld(&bar[XB_XCNT(j)]); sum += c; cnt += (c > 0u) ? 1u : 0u; mine = (j == x) ? c : mine; }
    if (sum == G) break;
    __builtin_amdgcn_s_sleep(1);
    if ((++sp & 255u) == 0u) { if (xb_ld(&bar[XB_TMO])) break; if (sp > XB_SPIN_CAP) { atomicAdd(&bar[XB_TMO], 1u); break; } }
  }
  nloc = mine > 0u ? mine : 1u; nx = cnt > 0u ? cnt : 1u;
}
__device__ __forceinline__ void xcd_barrier(const XcdBarrier& b) {
  asm volatile("s_waitcnt vmcnt(0)" ::: "memory");
  __syncthreads();
  if (threadIdx.x == 0) {
    unsigned* bar = b.bar;
    __builtin_amdgcn_s_waitcnt(0);
    unsigned nloc = b.st[0], nx = b.st[1];
    if (nloc == 0u) { xcd_barrier_complete(bar, b.x, nloc, nx); b.st[0] = nloc; b.st[1] = nx; }
    const unsigned old = xb_add(&bar[XB_XSUB(b.x)], 1u);
    const unsigned gen = old / nloc;
    if (old + 1u == (gen + 1u) * nloc) {
      __builtin_amdgcn_fence(__ATOMIC_RELEASE, "agent");
      asm volatile("s_waitcnt vmcnt(0)" ::: "memory");
      const unsigned og = xb_add(&bar[XB_TOP], 1u);
      const unsigned tg = og / nx;
      if (og + 1u == (tg + 1u) * nx) xb_add(&bar[XB_TOPGEN], 1u);
      else XB_SPIN(xb_ld(&bar[XB_TOPGEN]) == tg, bar);
      __builtin_amdgcn_fence(__ATOMIC_ACQUIRE, "agent");
      xb_add(&bar[XB_XGEN(b.x)], 1u);
      asm volatile("s_waitcnt vmcnt(0)" ::: "memory");
    } else {
      XB_SPIN(xb_ld(&bar[XB_XGEN(b.x)]) == gen, bar);
      __builtin_amdgcn_fence(__ATOMIC_ACQUIRE, "agent");
      asm volatile("s_waitcnt vmcnt(0)" ::: "memory");
    }
  }
  __syncthreads();
}

__device__ __forceinline__ void transpose_tile(const float* __restrict__ src, int ld_src, int k0, int n0, bf16_t* __restrict__ dst, int ld_dst,
                               int ndst0, int kdst0, const float* __restrict__ scale, float* sm, const float* __restrict__ scale_sub = nullptr) {
  const int tid = opaque_tid();
#pragma unroll
  for (int i = 0; i < 8; i++) {
    int k = (tid >> 6) + i * 8, n = tid & 63;
    float v = src[(size_t)(k0 + k) * ld_src + n0 + n];
    if (scale) v *= (scale_sub ? (scale[k0 + k] - scale_sub[k0 + k]) : scale[k0 + k]);
    sm[k * 65 + n] = v;
  }
  __syncthreads();
#pragma unroll
  for (int i = 0; i < 2; i++) {
    const int kk = tid & 15, n = (tid >> 4) + i * 32;
    const float* sp = sm + (kk * 4) * 65 + n;
    *(uint2*)(dst + (size_t)(ndst0 + n) * ld_dst + kdst0 + kk * 4) = make_uint2(pack2(sp[0], sp[65]), pack2(sp[130], sp[195]));
  }
  __syncthreads();
}

__device__ __forceinline__ void phase_prep(const Params& p, unsigned char* lds, int u_lo, int u_hi) {
  const int tid = opaque_tid();
  float* sm = (float*)lds;
  unsigned char* ws = p.ws;
  for (int u = u_lo + blockIdx.x; u < u_hi; u += gridDim.x) {
    if (u < 384) {
      const int layer = u / 192, j0 = (u % 192) * 16;
      const float* c = p.in[1];
      const float* W = layer ? p.in[22] : p.in[2];
      const float* bias = layer ? p.in[23] : p.in[3];
      float* mod = (float*)(ws + (layer ? OFF_MODB : OFF_MODA));
      float* sc = sm;
      float* red = sm + 8192;
      for (int i = tid; i < 8192; i += NTHREADS) { float cv = c[i]; sc[i] = cv * __builtin_amdgcn_rcpf(1.0f + __expf(-cv)); }
      __syncthreads();
      const int cl = tid & 15, ds = tid >> 4;
      float acc[8];
#pragma unroll
      for (int b = 0; b < 8; b++) acc[b] = 0.f;
#pragma unroll 8
      for (int d = ds * 32; d < ds * 32 + 32; d++) {
        float w = W[(size_t)d * 3072 + j0 + cl];
#pragma unroll
        for (int b = 0; b < 8; b++) acc[b] += sc[b * 1024 + d] * w;
      }
#pragma unroll
      for (int b = 0; b < 8; b++) red[(ds * 8 + b) * 16 + cl] = acc[b];
      __syncthreads();
      if (tid < 128) {
        const int b = tid >> 4;
        float s = bias[j0 + cl];
#pragma unroll
        for (int d2 = 0; d2 < 32; d2++) s += red[(d2 * 8 + b) * 16 + cl];
        mod[b * 3072 + j0 + cl] = s;
      }
      __syncthreads();
    } else if (u < 512) {
      const int idx = (u - 384) * 512 + tid;
      const int pos = idx >> 5, i = idx & 31;
      float invf = exp2f(-((float)i * (1.0f / 32.0f)) * 13.287712379549449f);
      float angf = (float)pos * invf;
      double rev = (double)angf * 0.15915494309189535;
      rev -= floor(rev);
      float rv = (float)rev;
      float* cs = (float*)(ws + OFF_ROPE);
      cs[idx] = __builtin_amdgcn_cosf(rv);
      cs[65536 + idx] = __builtin_amdgcn_sinf(rv);
    } else {
      int t = u - 512;
      if (t < 1024) {
        transpose_tile(p.in[6], 4096, (t & 15) * 64, (t >> 4) * 64, (bf16_t*)(ws + OFF_WT_AIN), 1024, (t >> 4) * 64, (t & 15) * 64, nullptr, sm);
      } else if ((t -= 1024) < 64) {
        const int job = t >> 4, kt = t & 15;
        const float* src = (job < 2) ? p.in[8] : p.in[11];
        const float* scale = (job == 1) ? (p.in[5] + 4 * 1024) : (job == 3) ? (p.in[5] + 5 * 1024) : nullptr;
        transpose_tile(src, 64, kt * 64, 0, (bf16_t*)(ws + OFF_WT_LORA1), 2048, (job >> 1) * 64, ((job & 1) ? 1024 : 0) + kt * 64, scale, sm, p.in[5]);
      } else if ((t -= 64) < 32) {
        const int job = t >> 4, nt = t & 15;
        transpose_tile(job ? p.in[12] : p.in[9], 1024, 0, nt * 64, (bf16_t*)(ws + (job ? OFF_WT_A2 : OFF_WT_W2)), 64, nt * 64, 0, nullptr, sm);
      } else if ((t -= 32) < 256) {
        transpose_tile(p.in[18], 1024, (t & 15) * 64, (t >> 4) * 64, (bf16_t*)(ws + OFF_WT_AOUT), 1024, (t >> 4) * 64, (t & 15) * 64, nullptr, sm);
      } else if ((t -= 256) < 512) {
        transpose_tile(p.in[20], 2048, (t & 15) * 64, (t >> 4) * 64, (bf16_t*)(ws + OFF_WT_KV), 1024, (t >> 4) * 64, (t & 15) * 64, nullptr, sm);
      } else if ((t -= 512) < 1024) {
        transpose_tile(p.in[25], 4096, (t & 15) * 64, (t >> 4) * 64, (bf16_t*)(ws + OFF_WT_BIN), 1024, (t >> 4) * 64, (t & 15) * 64, nullptr, sm);
      } else {
        t -= 1024;
        transpose_tile(p.in[27], 1024, (t & 15) * 64, (t >> 4) * 64, (bf16_t*)(ws + OFF_WT_BOUT), 1024, (t >> 4) * 64, (t & 15) * 64, nullptr, sm);
      }
    }
  }
}

__device__ __forceinline__ void phase_mix(const Params& p) {
  const int tid_ = opaque_tid(); const int lane = tid_ & 63, wave = tid_ >> 6;
  unsigned char* ws = p.ws;
  const float* x = p.in[0];
  const float* ng = p.in[4];
  const float* mu = p.in[5];
  const float* modA = (const float*)(ws + OFF_MODA);
  bf16_t* H = (bf16_t*)(ws + 1 * SLOT);
  bf16_t* XX = (bf16_t*)(ws + 3 * SLOT);
  bf16_t* XS0 = (bf16_t*)((unsigned char*)p.out);
  bf16_t* XS1 = (bf16_t*)((unsigned char*)p.out + SLOT);
  bf16_t* XS2 = (bf16_t*)(ws + 2 * SLOT);
  bf16_t* XS3 = (bf16_t*)(ws + 7 * SLOT);
  for (int u = blockIdx.x; u < T_TOK / 8; u += gridDim.x) {
    const int t = u * 8 + wave;
    const int b = t >> 11, s = t & 2047;
    const float4* xr = (const float4*)(x + (size_t)t * DM);
    const float4* xp = (const float4*)(x + (size_t)(t - 1) * DM);
    float4 cur[4], prv[4];
    float ss = 0.f, ssp = 0.f;
#pragma unroll
    for (int i = 0; i < 4; i++) {
      cur[i] = xr[(i >> 1) * 128 + lane * 2 + (i & 1)];
      ss += cur[i].x * cur[i].x + cur[i].y * cur[i].y + cur[i].z * cur[i].z + cur[i].w * cur[i].w;
    }
    if (s > 0) {
#pragma unroll
      for (int i = 0; i < 4; i++) {
        prv[i] = xp[(i >> 1) * 128 + lane * 2 + (i & 1)];
        ssp += prv[i].x * prv[i].x + prv[i].y * prv[i].y + prv[i].z * prv[i].z + prv[i].w * prv[i].w;
      }
    } else {
#pragma unroll
      for (int i = 0; i < 4; i++) prv[i] = make_float4(0.f, 0.f, 0.f, 0.f);
    }
    ss = wave_sum(ss);
    ssp = wave_sum(ssp);
    const float rinv = __builtin_amdgcn_rsqf(ss * (1.0f / 1024.0f) + 1e-6f);
    const float rinvp = __builtin_amdgcn_rsqf(ssp * (1.0f / 1024.0f) + 1e-6f);
#pragma unroll
    for (int jp = 0; jp < 2; jp++) {
      const int d = jp * 512 + lane * 8;
      float hc[8], hx[8];
#pragma unroll
      for (int hf = 0; hf < 2; hf++) {
        const int i = jp * 2 + hf;
        const float4 g4 = *(const float4*)(ng + d + hf * 4);
        const float4 sh4 = *(const float4*)(modA + b * 3072 + d + hf * 4);
        const float4 sc4 = *(const float4*)(modA + b * 3072 + 1024 + d + hf * 4);
        const float cv[4] = {cur[i].x, cur[i].y, cur[i].z, cur[i].w};
        const float pv[4] = {prv[i].x, prv[i].y, prv[i].z, prv[i].w};
        const float gg[4] = {g4.x, g4.y, g4.z, g4.w};
        const float sh[4] = {sh4.x, sh4.y, sh4.z, sh4.w};
        const float sc[4] = {sc4.x, sc4.y, sc4.z, sc4.w};
#pragma unroll
        for (int e = 0; e < 4; e++) {
          float h = cv[e] * rinv * gg[e] * (1.0f + sc[e]) + sh[e];
          float hp = (s > 0) ? (pv[e] * rinvp * gg[e] * (1.0f + sc[e]) + sh[e]) : 0.f;
          hc[hf * 4 + e] = h;
          hx[hf * 4 + e] = hp - h;
        }
      }
      const size_t o = (size_t)t * DM + d;
      *(uint4*)(XX + o) = make_uint4(pack2(hx[0], hx[1]), pack2(hx[2], hx[3]), pack2(hx[4], hx[5]), pack2(hx[6], hx[7]));
#pragma unroll
      for (int q = 0; q < 4; q++) {
        const float4 m0 = *(const float4*)(mu + q * 1024 + d);
        const float4 m1 = *(const float4*)(mu + q * 1024 + d + 4);
        const float mm[8] = {m0.x, m0.y, m0.z, m0.w, m1.x, m1.y, m1.z, m1.w};
        float v[8];
#pragma unroll
        for (int e = 0; e < 8; e++) v[e] = hc[e] + hx[e] * mm[e];
        bf16_t* dst = (q == 0) ? XS0 : (q == 1) ? XS1 : (q == 2) ? XS2 : XS3;
        *(uint4*)(dst + o) = make_uint4(pack2(v[0], v[1]), pack2(v[2], v[3]), pack2(v[4], v[5]), pack2(v[6], v[7]));
      }
    }
  }
}

struct GemmArgs {
  const bf16_t* A0; const bf16_t* A1; int ksplit; int lda;
  const bf16_t* Bt; int ldb; int K;
};

constexpr int G_LDA = 64;
constexpr int G_ASTAGE = 256 * G_LDA;
constexpr int G_BSTAGE = 128 * G_LDA;
template <class Epi>
__device__ __forceinline__ void gemm_tile(const GemmArgs& g, int m0, int n0, unsigned char* lds, const Epi& epi) {
  const int tid = opaque_tid(), lane = tid & 63, wave = tid >> 6;
  const int wm = wave & 3, wn = wave >> 2;
  const int fr = lane & 15, fq = lane >> 4;
  bf16_t* As = (bf16_t*)lds;
  bf16_t* Bs = (bf16_t*)(lds + 2 * G_ASTAGE * 2);
  f32x4 acc[4][4];
#pragma unroll
  for (int i = 0; i < 4; i++)
#pragma unroll
    for (int j = 0; j < 4; j++) acc[i][j] = (f32x4){0.f, 0.f, 0.f, 0.f};
  const int lr = tid >> 3, lk = (tid & 7) * 8;
  const int lkw = ((tid & 7) ^ ((lr >> 1) & 7)) * 8;
  const int rsw = (fr >> 1) & 7;
  uint4 ra0_0, ra0_1, ra0_2, ra0_3, ra1_0, ra1_1, ra1_2, ra1_3, rb0_0, rb0_1, rb1_0, rb1_1;
  const int nk = g.K >> 6;
  const bf16_t* arow0 = g.A0 + (size_t)(m0 + lr) * g.lda + lk;
  const bf16_t* arow1 = g.A1 + (size_t)(m0 + lr) * g.lda + lk - g.ksplit;
  const bf16_t* brow = g.Bt + (size_t)(n0 + lr) * g.ldb + lk;
  const size_t a64 = (size_t)64 * g.lda, b64 = (size_t)64 * g.ldb;
#define G_LOAD(SET, KT)                                                                   \
  {                                                                                       \
    const int kg_ = (KT) * 64;                                                            \
    const bf16_t* ab_ = ((kg_ < g.ksplit) ? arow0 : arow1) + kg_;                         \
    ra##SET##_0 = *(const uint4*)(ab_);                                                   \
    ra##SET##_1 = *(const uint4*)(ab_ + a64);                                             \
    ra##SET##_2 = *(const uint4*)(ab_ + 2 * a64);                                         \
    ra##SET##_3 = *(const uint4*)(ab_ + 3 * a64);                                         \
    rb##SET##_0 = *(const uint4*)(brow + kg_);                                            \
    rb##SET##_1 = *(const uint4*)(brow + kg_ + b64);                                      \
  }
#define G_WRITE(SET, ST)                                                                  \
  {                                                                                       \
    bf16_t* aw_ = As + (ST) * G_ASTAGE + lr * G_LDA + lkw;                                \
    bf16_t* bw_ = Bs + (ST) * G_BSTAGE + lr * G_LDA + lkw;                                \
    *(uint4*)(aw_) = ra##SET##_0;                                                         \
    *(uint4*)(aw_ + 64 * G_LDA) = ra##SET##_1;                                            \
    *(uint4*)(aw_ + 128 * G_LDA) = ra##SET##_2;                                           \
    *(uint4*)(aw_ + 192 * G_LDA) = ra##SET##_3;                                           \
    *(uint4*)(bw_) = rb##SET##_0;                                                         \
    *(uint4*)(bw_ + 64 * G_LDA) = rb##SET##_1;                                            \
  }
#define G_COMPUTE(ST)                                                                     \
  {                                                                                       \
    const bf16_t* Asr_ = As + (ST) * G_ASTAGE + (wm * 64 + fr) * G_LDA;                   \
    const bf16_t* Bsr_ = Bs + (ST) * G_BSTAGE + (wn * 64 + fr) * G_LDA;                   \
    _Pragma("unroll") for (int ks_ = 0; ks_ < 2; ks_++) {                                 \
      bf16x8 a_[4], b_[4];                                                                \
      const int go_ = ((ks_ * 4 + fq) ^ rsw) * 8;                                         \
      _Pragma("unroll") for (int i_ = 0; i_ < 4; i_++) a_[i_] = *(const bf16x8*)(Asr_ + i_ * 16 * G_LDA + go_); \
      _Pragma("unroll") for (int i_ = 0; i_ < 4; i_++) b_[i_] = *(const bf16x8*)(Bsr_ + i_ * 16 * G_LDA + go_); \
      _Pragma("unroll") for (int i_ = 0; i_ < 4; i_++)                                    \
        _Pragma("unroll") for (int j_ = 0; j_ < 4; j_++)                                  \
          acc[i_][j_] = __builtin_amdgcn_mfma_f32_16x16x32_bf16(b_[j_], a_[i_], acc[i_][j_], 0, 0, 0); \
    }                                                                                     \
  }
  G_LOAD(0, 0);
  if (nk > 1) G_LOAD(1, 1);
  G_WRITE(0, 0);
  __syncthreads();
  for (int kt = 0; kt < nk; kt += 2) {
    if (kt + 2 < nk) G_LOAD(0, kt + 2);
    __builtin_amdgcn_sched_barrier(0);
    G_COMPUTE(0);
    if (kt + 1 < nk) G_WRITE(1, 1);
    __syncthreads();
    if (kt + 1 < nk) {
      if (kt + 3 < nk) G_LOAD(1, kt + 3);
      __builtin_amdgcn_sched_barrier(0);
      G_COMPUTE(1);
      if (kt + 2 < nk) G_WRITE(0, 0);
      __syncthreads();
    }
  }
#undef G_LOAD
#undef G_WRITE
#undef G_COMPUTE
  epi(acc, m0 + wm * 64, n0 + wn * 64, fr, fq);
}

constexpr int G2_STAGE = 256 * G_LDA;
template <class Epi>
__device__ __forceinline__ void gemm_tile256(const GemmArgs& g, int m0, int n0, unsigned char* lds, const Epi& epi) {
  const int tid = opaque_tid(), lane = tid & 63, wave = tid >> 6;
  const int wm = wave & 1, wn = wave >> 1;
  const int fr = lane & 15, fq = lane >> 4;
  bf16_t* As = (bf16_t*)lds;
  bf16_t* Bs = (bf16_t*)(lds + 2 * G2_STAGE * 2);
  f32x4 acc[2][4][4];
#pragma unroll
  for (int h = 0; h < 2; h++)
#pragma unroll
    for (int i = 0; i < 4; i++)
#pragma unroll
      for (int j = 0; j < 4; j++) acc[h][i][j] = (f32x4){0.f, 0.f, 0.f, 0.f};
  const int lr = tid >> 3;
  const int lkg = ((tid & 7) ^ ((lr >> 1) & 7)) * 8;
  const int rsw = (fr >> 1) & 7;
  const int nk = g.K >> 6;
  const bf16_t* arow0 = g.A0 + (size_t)(m0 + lr) * g.lda + lkg;
  const bf16_t* arow1 = g.A1 + (size_t)(m0 + lr) * g.lda + lkg - g.ksplit;
  const int lrp = (lr & ~31) + 8 * ((lr & 15) >> 2) + 4 * ((lr >> 4) & 1) + (lr & 3);
  const bf16_t* brow = g.Bt + (size_t)(n0 + lrp) * g.ldb + lkg;
  const size_t a64 = (size_t)64 * g.lda, b64 = (size_t)64 * g.ldb;
  bf16_t* lds_a = As + tid * 8;
  bf16_t* lds_b = Bs + tid * 8;
#define G2_STAGE_IN(KT, ST)                                                               \
  {                                                                                       \
    const int kg_ = (KT) * 64;                                                            \
    const bf16_t* ab_ = ((kg_ < g.ksplit) ? arow0 : arow1) + kg_;                         \
    _Pragma("unroll") for (int i_ = 0; i_ < 4; i_++) {                                    \
      __builtin_amdgcn_global_load_lds((const unsigned*)(ab_ + i_ * a64), (unsigned*)(lds_a + (ST) * G2_STAGE + i_ * 64 * G_LDA), 16, 0, 0); \
      __builtin_amdgcn_global_load_lds((const unsigned*)(brow + kg_ + i_ * b64), (unsigned*)(lds_b + (ST) * G2_STAGE + i_ * 64 * G_LDA), 16, 0, 0); \
    }                                                                                     \
  }
#define G2_COMPUTE(ST)                                                                    \
  {                                                                                       \
    const bf16_t* Asr_ = As + (ST) * G2_STAGE + (wm * 128 + fr) * G_LDA;                  \
    const bf16_t* Bsr_ = Bs + (ST) * G2_STAGE + (wn * 64 + fr) * G_LDA;                   \
    const int go0_ = ((0 + fq) ^ rsw) * 8, go1_ = ((4 + fq) ^ rsw) * 8;                   \
    bf16x8 bb_[2][4], aa_[16];                                                            \
    _Pragma("unroll") for (int i_ = 0; i_ < 4; i_++) bb_[0][i_] = *(const bf16x8*)(Bsr_ + i_ * 16 * G_LDA + go0_); \
    _Pragma("unroll") for (int q_ = 0; q_ < 3; q_++) aa_[q_] = *(const bf16x8*)(Asr_ + (((q_ >> 2) & 1) * 64 + (q_ & 3) * 16) * G_LDA + go0_); \
    _Pragma("unroll") for (int q_ = 0; q_ < 16; q_++) {                                   \
      if (q_ + 3 < 16) {                                                                  \
        const int p_ = q_ + 3;                                                            \
        aa_[p_] = *(const bf16x8*)(Asr_ + (((p_ >> 2) & 1) * 64 + (p_ & 3) * 16) * G_LDA + ((p_ >> 3) ? go1_ : go0_)); \
      }                                                                                   \
      if (q_ == 4) {                                                                      \
        _Pragma("unroll") for (int i_ = 0; i_ < 4; i_++) bb_[1][i_] = *(const bf16x8*)(Bsr_ + i_ * 16 * G_LDA + go1_); \
      }                                                                                   \
      __builtin_amdgcn_sched_barrier(0);                                                  \
      _Pragma("unroll") for (int j_ = 0; j_ < 4; j_++)                                    \
        acc[(q_ >> 2) & 1][q_ & 3][j_] = __builtin_amdgcn_mfma_f32_16x16x32_bf16(bb_[q_ >> 3][j_], aa_[q_], acc[(q_ >> 2) & 1][q_ & 3][j_], 0, 0, 0); \
      __builtin_amdgcn_sched_barrier(0);                                                  \
    }                                                                                     \
  }
  G2_STAGE_IN(0, 0);
  asm volatile("s_waitcnt vmcnt(0)" ::: "memory");
  __syncthreads();
  for (int kt = 0; kt < nk; kt++) {
    const int st = kt & 1;
    if (kt + 1 < nk) G2_STAGE_IN(kt + 1, st ^ 1);
    G2_COMPUTE(st);
    asm volatile("s_waitcnt vmcnt(0)" ::: "memory");
    __syncthreads();
  }
#undef G2_STAGE_IN
#undef G2_COMPUTE
  epi(acc[0], m0 + wm * 128, n0 + wn * 64, fr, fq);
  __builtin_amdgcn_sched_barrier(0);
  epi(acc[1], m0 + wm * 128 + 64, n0 + wn * 64, fr, fq);
}

__device__ __forceinline__ uint2 pack4(float a, float b, float c, float d) { return make_uint2(pack2(a, b), pack2(c, d)); }
__device__ __forceinline__ float quad_sum(float v) {
  v += __shfl_xor(v, 16);
  v += __shfl_xor(v, 32);
  return v;
}
#define PCOL(ni) (((ni) >> 1) * 32 + fq * 8 + ((ni) & 1) * 4)
struct EpiStoreBf16 {
  bf16_t* dst; int ldd; int coff;
  __device__ __forceinline__ void operator()(f32x4 (&acc)[4][4], int m0w, int n0w, int fr, int fq) const {
#pragma unroll
    for (int mi = 0; mi < 4; mi++) {
      const size_t row = m0w + mi * 16 + fr;
#pragma unroll
      for (int pp = 0; pp < 2; pp++) {
        const uint2 lo = pack4(acc[mi][2 * pp][0], acc[mi][2 * pp][1], acc[mi][2 * pp][2], acc[mi][2 * pp][3]);
        const uint2 hi = pack4(acc[mi][2 * pp + 1][0], acc[mi][2 * pp + 1][1], acc[mi][2 * pp + 1][2], acc[mi][2 * pp + 1][3]);
        *(uint4*)(dst + row * ldd + coff + n0w + pp * 32 + fq * 8) = make_uint4(lo.x, lo.y, hi.x, hi.y);
      }
    }
  }
};
struct EpiLora1 {
  bf16_t* dst;
  __device__ __forceinline__ void operator()(f32x4 (&acc)[4][4], int m0w, int n0w, int fr, int fq) const {
#pragma unroll
    for (int mi = 0; mi < 4; mi++) {
      const size_t row = m0w + mi * 16 + fr;
#pragma unroll
      for (int ni = 0; ni < 4; ni++) {
        float v[4];
#pragma unroll
        for (int j = 0; j < 4; j++) { v[j] = acc[mi][ni][j]; if (n0w < 64) v[j] = 2.0f * __builtin_amdgcn_rcpf(1.0f + __expf(-2.0f * v[j])) - 1.0f;     }
        *(uint2*)(dst + row * 128 + n0w + ni * 16 + fq * 4) = pack4(v[0], v[1], v[2], v[3]);
      }
    }
  }
};
struct EpiLora2W {
  bf16_t* dst; const float* w0;
  __device__ __forceinline__ void operator()(f32x4 (&acc)[4][4], int m0w, int n0w, int fr, int fq) const {
#pragma unroll
    for (int ni = 0; ni < 4; ni++) {
      const int col = n0w + ni * 16 + fq * 4;
      const float4 bias = *(const float4*)(w0 + col);
#pragma unroll
      for (int mi = 0; mi < 4; mi++) {
        const size_t row = m0w + mi * 16 + fr;
        *(uint2*)(dst + row * DM + col) = pack4(0.6065306597126334f * sigmoidf_(acc[mi][ni][0] + bias.x), 0.6065306597126334f * sigmoidf_(acc[mi][ni][1] + bias.y),
                                                0.6065306597126334f * sigmoidf_(acc[mi][ni][2] + bias.z), 0.6065306597126334f * sigmoidf_(acc[mi][ni][3] + bias.w));
      }
    }
  }
};
struct EpiLora2A {
  bf16_t* dst; const float* a0;
  __device__ __forceinline__ void operator()(f32x4 (&acc)[4][4], int m0w, int n0w, int fr, int fq) const {
#pragma unroll
    for (int ni = 0; ni < 4; ni++) {
      const int col = n0w + ni * 16 + fq * 4;
      const float4 bias = *(const float4*)(a0 + col);
#pragma unroll
      for (int mi = 0; mi < 4; mi++) {
        const size_t row = m0w + mi * 16 + fr;
        *(uint2*)(dst + row * DM + col) = pack4(sigmoidf_(acc[mi][ni][0] + bias.x), sigmoidf_(acc[mi][ni][1] + bias.y),
                                                sigmoidf_(acc[mi][ni][2] + bias.z), sigmoidf_(acc[mi][ni][3] + bias.w));
      }
    }
  }
};
struct EpiGPost {
  const bf16_t* Y; const bf16_t* RKV; const float* BONUS;
  const float* ln_g; const float* ln_b;
  bf16_t* dst;
  __device__ __forceinline__ void operator()(f32x4 (&acc)[4][4], int m0w, int n0w, int fr, int fq) const {
#pragma unroll
    for (int mi = 0; mi < 4; mi++) {
      const size_t row = m0w + mi * 16 + fr;
      float yv[2][8], vv[2][8];
      float sy = 0.f;
      const float sb = BONUS[row * 16 + (n0w >> 6)];
#pragma unroll
      for (int pp = 0; pp < 2; pp++) {
        const int col = n0w + pp * 32 + fq * 8;
        const uint4 y4 = *(const uint4*)(Y + row * DM + col);
        const uint4 v4 = *(const uint4*)(RKV + row * 3072 + 2048 + col);
        const unsigned yu[4] = {y4.x, y4.y, y4.z, y4.w};
        const unsigned vu[4] = {v4.x, v4.y, v4.z, v4.w};
#pragma unroll
        for (int q = 0; q < 4; q++) {
#pragma unroll
          for (int hl = 0; hl < 2; hl++) {
            const int e = q * 2 + hl;
            const float yy = hl ? hi_bf(yu[q]) : lo_bf(yu[q]);
            const float vx = hl ? hi_bf(vu[q]) : lo_bf(vu[q]);
            yv[pp][e] = yy; vv[pp][e] = vx;
            sy += yy;
          }
        }
      }
      sy = quad_sum(sy);
      const float mean = sy * (1.0f / 64.0f);
      float sv = 0.f;
#pragma unroll
      for (int pp = 0; pp < 2; pp++)
#pragma unroll
        for (int e = 0; e < 8; e++) { const float d = yv[pp][e] - mean; sv += d * d; }
      sv = quad_sum(sv);
      const float rstd = __builtin_amdgcn_rsqf(sv * (1.0f / 64.0f) + 64e-5f);
#pragma unroll
      for (int pp = 0; pp < 2; pp++) {
        const int col = n0w + pp * 32 + fq * 8;
        const float4 lg0 = *(const float4*)(ln_g + col), lg1 = *(const float4*)(ln_g + col + 4);
        const float4 lb0 = *(const float4*)(ln_b + col), lb1 = *(const float4*)(ln_b + col + 4);
        const float lgc[8] = {lg0.x, lg0.y, lg0.z, lg0.w, lg1.x, lg1.y, lg1.z, lg1.w};
        const float lbc[8] = {lb0.x, lb0.y, lb0.z, lb0.w, lb1.x, lb1.y, lb1.z, lb1.w};
        float o[8];
#pragma unroll
        for (int e = 0; e < 8; e++) {
          const float yn = (yv[pp][e] - mean) * rstd * lgc[e] + lbc[e];
          const float gp = acc[mi][2 * pp + (e >> 2)][e & 3];
          o[e] = (yn + sb * vv[pp][e]) * (gp * sigmoidf_(gp));
        }
        *(uint4*)(dst + row * DM + col) = make_uint4(pack2(o[0], o[1]), pack2(o[2], o[3]), pack2(o[4], o[5]), pack2(o[6], o[7]));
      }
      __builtin_amdgcn_sched_barrier(0);
    }
  }
};
struct EpiResidual {
  const float* res; const float* gate; float* dst;
  __device__ __forceinline__ void operator()(f32x4 (&acc)[4][4], int m0w, int n0w, int fr, int fq) const {
    const int b = m0w >> 11;
    float4 gt[4];
#pragma unroll
    for (int ni = 0; ni < 4; ni++) gt[ni] = *(const float4*)(gate + b * 3072 + n0w + PCOL(ni));
#pragma unroll
    for (int mi = 0; mi < 4; mi++) {
      const size_t row = m0w + mi * 16 + fr;
#pragma unroll
      for (int ni = 0; ni < 4; ni++) {
        const size_t o = row * DM + n0w + PCOL(ni);
        const float4 r = *(const float4*)(res + o);
        float4 w;
        w.x = r.x + gt[ni].x * acc[mi][ni][0];
        w.y = r.y + gt[ni].y * acc[mi][ni][1];
        w.z = r.z + gt[ni].z * acc[mi][ni][2];
        w.w = r.w + gt[ni].w * acc[mi][ni][3];
        *(float4*)(dst + o) = w;
      }
      __builtin_amdgcn_sched_barrier(0);
    }
  }
};
__device__ __forceinline__ void headnorm_rope_store(f32x4 (&acc)[4][4], int m0w, int fr, int fq, bf16_t* dst, int dcol,
                                                    const float* gain, float scale, const float* cs, const float* sn) {
  float gn[4][4];
#pragma unroll
  for (int ni = 0; ni < 4; ni++) {
    const float4 g4 = *(const float4*)(gain + PCOL(ni));
    gn[ni][0] = g4.x; gn[ni][1] = g4.y; gn[ni][2] = g4.z; gn[ni][3] = g4.w;
  }
#pragma unroll
  for (int mi = 0; mi < 4; mi++) {
    const size_t row = m0w + mi * 16 + fr;
    const int pos = (int)(row & 2047);
    float ss = 0.f;
#pragma unroll
    for (int ni = 0; ni < 4; ni++)
#pragma unroll
      for (int j = 0; j < 4; j++) ss += acc[mi][ni][j] * acc[mi][ni][j];
    ss = quad_sum(ss);
    const float rinv = __builtin_amdgcn_rsqf(ss * (1.0f / 64.0f) + 1e-6f) * scale;
    const float4 c0 = *(const float4*)(cs + pos * 32 + fq * 8), s0 = *(const float4*)(sn + pos * 32 + fq * 8);
    const float4 c1 = *(const float4*)(cs + pos * 32 + fq * 8 + 4), s1 = *(const float4*)(sn + pos * 32 + fq * 8 + 4);
    const float cc0[4] = {c0.x, c0.y, c0.z, c0.w}, ss0[4] = {s0.x, s0.y, s0.z, s0.w};
    const float cc1[4] = {c1.x, c1.y, c1.z, c1.w}, ss1[4] = {s1.x, s1.y, s1.z, s1.w};
    float o0[4], o1[4], o2[4], o3[4];
#pragma unroll
    for (int j = 0; j < 4; j++) {
      const float v0 = acc[mi][0][j] * rinv * gn[0][j], v1 = acc[mi][1][j] * rinv * gn[1][j];
      const float v2 = acc[mi][2][j] * rinv * gn[2][j], v3 = acc[mi][3][j] * rinv * gn[3][j];
      o0[j] = v0 * cc0[j] - v2 * ss0[j];
      o2[j] = v2 * cc0[j] + v0 * ss0[j];
      o1[j] = v1 * cc1[j] - v3 * ss1[j];
      o3[j] = v3 * cc1[j] + v1 * ss1[j];
    }
    bf16_t* d = dst + row * DM + dcol + fq * 8;
    {
      const uint2 a = pack4(o0[0], o0[1], o0[2], o0[3]), bq = pack4(o1[0], o1[1], o1[2], o1[3]);
      const uint2 c = pack4(o2[0], o2[1], o2[2], o2[3]), e = pack4(o3[0], o3[1], o3[2], o3[3]);
      *(uint4*)(d) = make_uint4(a.x, a.y, bq.x, bq.y);
      *(uint4*)(d + 32) = make_uint4(c.x, c.y, e.x, e.y);
    }
    __builtin_amdgcn_sched_barrier(0);
  }
}
struct EpiKV {
  bf16_t* KSH; bf16_t* VSH; const float* kg; const float* cs; const float* sn;
  __device__ __forceinline__ void operator()(f32x4 (&acc)[4][4], int m0w, int n0w, int fr, int fq) const {
    if (n0w < 1024) {
      headnorm_rope_store(acc, m0w, fr, fq, KSH, n0w, kg, 1.0f, cs, sn);
    } else {
      EpiStoreBf16 e{VSH, DM, -1024};
      e(acc, m0w, n0w, fr, fq);
    }
  }
};
struct EpiQ {
  bf16_t* Q0; bf16_t* Q1; bf16_t* Q2; const float* qg; const float* cs; const float* sn;
  __device__ __forceinline__ void operator()(f32x4 (&acc)[4][4], int m0w, int n0w, int fr, int fq) const {
    const int g = n0w >> 10;
    bf16_t* Q = (g == 0) ? Q0 : (g == 1) ? Q1 : Q2;
    headnorm_rope_store(acc, m0w, fr, fq, Q, n0w & 1023, qg, 0.18033688011112042f, cs, sn);
  }
};
struct EpiMerge {
  const bf16_t* O0; const bf16_t* O1; const bf16_t* O2; const float2* ML; bf16_t* dst;
  __device__ __forceinline__ void operator()(f32x4 (&acc)[4][4], int m0w, int n0w, int fr, int fq) const {
    const int h = n0w >> 6;
#pragma unroll
    for (int mi = 0; mi < 4; mi++) {
      const size_t row = m0w + mi * 16 + fr;
      const float2 a0 = ML[(0 * (size_t)T_TOK + row) * 16 + h];
      const float2 a1 = ML[(1 * (size_t)T_TOK + row) * 16 + h];
      const float2 a2 = ML[(2 * (size_t)T_TOK + row) * 16 + h];
      const float M = fmaxf(a0.x, fmaxf(a1.x, a2.x));
      const float w0 = __builtin_amdgcn_exp2f(a0.x - M) * a0.y, w1 = __builtin_amdgcn_exp2f(a1.x - M) * a1.y, w2 = __builtin_amdgcn_exp2f(a2.x - M) * a2.y;
      const float inv = __builtin_amdgcn_rcpf(w0 + w1 + w2);
#pragma unroll
      for (int pp = 0; pp < 2; pp++) {
        const size_t o = row * DM + n0w + pp * 32 + fq * 8;
        const uint4 p0 = *(const uint4*)(O0 + o), p1 = *(const uint4*)(O1 + o), p2 = *(const uint4*)(O2 + o);
        const unsigned u0[4] = {p0.x, p0.y, p0.z, p0.w}, u1[4] = {p1.x, p1.y, p1.z, p1.w}, u2[4] = {p2.x, p2.y, p2.z, p2.w};
        unsigned out[4];
#pragma unroll
        for (int q = 0; q < 4; q++) {
          const float lo = (w0 * lo_bf(u0[q]) + w1 * lo_bf(u1[q]) + w2 * lo_bf(u2[q])) * inv;
          const float hi = (w0 * hi_bf(u0[q]) + w1 * hi_bf(u1[q]) + w2 * hi_bf(u2[q])) * inv;
          const float g0 = acc[mi][2 * pp + (q >> 1)][(q & 1) * 2], g1 = acc[mi][2 * pp + (q >> 1)][(q & 1) * 2 + 1];
          out[q] = pack2(lo * g0 * sigmoidf_(g0), hi * g1 * sigmoidf_(g1));
        }
        *(uint4*)(dst + o) = make_uint4(out[0], out[1], out[2], out[3]);
      }
      __builtin_amdgcn_sched_barrier(0);
    }
  }
};

typedef float v2f __attribute__((ext_vector_type(2)));
__device__ __forceinline__ v2f pkfma_lo(v2f a, v2f b, v2f c) { v2f d; asm("v_pk_fma_f32 %0, %1, %2, %3 op_sel_hi:[1,0,1]" : "=v"(d) : "v"(a), "v"(b), "v"(c)); return d; }
__device__ __forceinline__ v2f pkfma_hi(v2f a, v2f b, v2f c) { v2f d; asm("v_pk_fma_f32 %0, %1, %2, %3 op_sel:[0,1,0]" : "=v"(d) : "v"(a), "v"(b), "v"(c)); return d; }
__device__ __forceinline__ v2f pkmul_lo(v2f a, v2f b) { v2f d; asm("v_pk_mul_f32 %0, %1, %2 op_sel_hi:[1,0]" : "=v"(d) : "v"(a), "v"(b)); return d; }
__device__ __forceinline__ v2f pkmul_hi(v2f a, v2f b) { v2f d; asm("v_pk_mul_f32 %0, %1, %2 op_sel:[0,1]" : "=v"(d) : "v"(a), "v"(b)); return d; }
constexpr int SC_STEP = 384;
constexpr int SC_CH = 16;
__device__ __forceinline__ void phase_scan(const Params& p, unsigned char* lds) {
  float* inbuf = (float*)lds;
  float* ybuf = (float*)(lds + 2 * SC_CH * SC_STEP * 4);
  const int tid = opaque_tid(), lane = tid & 63, wave = tid >> 6;
  unsigned char* ws = p.ws;
  const bf16_t* RKV = (const bf16_t*)(ws + 4 * SLOT);
  const bf16_t* WDEC = (const bf16_t*)(ws + 3 * SLOT);
  const bf16_t* AICL = (const bf16_t*)(ws + 1 * SLOT);
  bf16_t* Y = (bf16_t*)(ws + 2 * SLOT);
  const float* k_k = p.in[13];
  const float* k_a = p.in[14];
  constexpr int NCH = SEQ / SC_CH;
  for (int tile = blockIdx.x; tile < 256; tile += gridDim.x) {
    const int b = tile >> 5, h = (tile >> 1) & 15, half = tile & 1;
    const size_t tok0 = (size_t)b * SEQ;
    if (wave >= 4) {
      const int lw = wave - 4, ss = lane >> 4, eg = lane & 15, e0 = eg * 4;
      const int stp = lw * 4 + ss;
      const float4 kk4 = *(const float4*)(k_k + h * 64 + e0);
      const float4 ka4 = *(const float4*)(k_a + h * 64 + e0);
      const float4 rk4 = *(const float4*)(p.in[15] + h * 64 + e0);
      float* BONUS = (float*)(ws + OFF_SPARE);
      uint2 r0, k0, a0, v0, r1, k1, a1, v1, r2, k2, a2, v2, w0, w1, w2;
      v0 = make_uint2(0, 0); v1 = v0; v2 = v0;
#define SC_GLOAD(S, CH)                                                                         \
      {                                                                                         \
        const size_t tok_ = tok0 + (size_t)(CH) * SC_CH + stp;                                  \
        r##S = *(const uint2*)(RKV + tok_ * 3072 + h * 64 + e0);                                \
        k##S = *(const uint2*)(RKV + tok_ * 3072 + 1024 + h * 64 + e0);                         \
        a##S = *(const uint2*)(AICL + tok_ * DM + h * 64 + e0);                                 \
        w##S = *(const uint2*)(WDEC + tok_ * DM + h * 64 + e0);                                 \
        if (eg < 8) v##S = *(const uint2*)(RKV + tok_ * 3072 + 2048 + h * 64 + half * 32 + eg * 4); \
      }
#define SC_ITER(S, C)                                                                           \
      {                                                                                         \
        const int c_ = (C);                                                                     \
        if (c_ + 1 < NCH) {                                                                     \
          const float r[4] = {lo_bf(r##S.x), hi_bf(r##S.x), lo_bf(r##S.y), hi_bf(r##S.y)};      \
          const float k[4] = {lo_bf(k##S.x), hi_bf(k##S.x), lo_bf(k##S.y), hi_bf(k##S.y)};      \
          const float a[4] = {lo_bf(a##S.x), hi_bf(a##S.x), lo_bf(a##S.y), hi_bf(a##S.y)};      \
          const float w[4] = {__expf(-lo_bf(w##S.x)), __expf(-hi_bf(w##S.x)), __expf(-lo_bf(w##S.y)), __expf(-hi_bf(w##S.y))}; \
          const float kkc[4] = {kk4.x, kk4.y, kk4.z, kk4.w};                                    \
          const float kac[4] = {ka4.x, ka4.y, ka4.z, ka4.w};                                    \
          float kkr[4], km[4];                                                                  \
          float n2 = 0.f;                                                                       \
          _Pragma("unroll") for (int i = 0; i < 4; i++) { kkr[i] = k[i] * kkc[i]; n2 += kkr[i] * kkr[i]; km[i] = k[i] * (1.0f + (a[i] - 1.0f) * kac[i]); } \
          n2 = row16_sum(n2);                                                                   \
          const float inv = __builtin_amdgcn_rsqf(fmaxf(n2, 1e-24f));                                        \
          float an[4], bv[4], wr[4];                                                            \
          float br = 0.f, kr = 0.f;                                                             \
          _Pragma("unroll") for (int i = 0; i < 4; i++) {                                       \
            const float kk = kkr[i] * inv;                                                      \
            an[i] = -kk; bv[i] = kk * a[i]; wr[i] = w[i] * r[i];                                \
            br += bv[i] * r[i]; kr += km[i] * r[i];                                             \
          }                                                                                     \
          float bn = r[0] * km[0] * rk4.x + r[1] * km[1] * rk4.y + r[2] * km[2] * rk4.z + r[3] * km[3] * rk4.w; \
          row16_sum3(br, kr, bn);                                                               \
          if (eg == 0 && half == 0) BONUS[(tok0 + (size_t)(c_ + 1) * SC_CH + stp) * 16 + h] = bn; \
          float* base = inbuf + (((c_ + 1) & 1) * SC_CH + stp) * SC_STEP;                       \
          *(float4*)(base + e0) = make_float4(w[0], w[1], w[2], w[3]);                          \
          *(float4*)(base + 64 + e0) = make_float4(bv[0], bv[1], bv[2], bv[3]);                 \
          *(float4*)(base + 128 + e0) = make_float4(km[0], km[1], km[2], km[3]);                \
          *(float4*)(base + 192 + e0) = make_float4(an[0], an[1], an[2], an[3]);                \
          *(float4*)(base + 256 + e0) = make_float4(wr[0], wr[1], wr[2], wr[3]);                \
          if (eg < 8) {                                                                         \
            *(float4*)(base + 320 + eg * 8) = make_float4(br, kr, lo_bf(v##S.x), hi_bf(v##S.x)); \
            *(float4*)(base + 324 + eg * 8) = make_float4(br, kr, lo_bf(v##S.y), hi_bf(v##S.y)); \
          }                                                                                     \
        }                                                                                       \
        if (c_ + 4 < NCH) SC_GLOAD(S, c_ + 4);                                                  \
        if (c_ >= 1) {                                                                          \
          const int idx = (tid - 256) * 2;                                                      \
          const int st_ = idx >> 5, rr = idx & 31;                                              \
          const float2 yv = *(const float2*)(ybuf + (((c_ + 1) & 1) * SC_CH + st_) * 32 + rr);  \
          *(unsigned*)(Y + (tok0 + (size_t)(c_ - 1) * SC_CH + st_) * DM + h * 64 + half * 32 + rr) = pack2(yv.x, yv.y); \
        }                                                                                       \
        __syncthreads();                                                                        \
      }
      SC_GLOAD(0, 0);
      SC_GLOAD(1, 1);
      SC_GLOAD(2, 2);
      for (int c = -1; c < NCH; c += 3) {
        SC_ITER(0, c);
        SC_ITER(1, c + 1);
        SC_ITER(2, c + 2);
      }
#undef SC_GLOAD
#undef SC_ITER
      {
        const int idx = (tid - 256) * 2;
        const int st = idx >> 5, rr = idx & 31;
        const float2 yv = *(const float2*)(ybuf + (((NCH - 1) & 1) * SC_CH + st) * 32 + rr);
        *(unsigned*)(Y + (tok0 + (size_t)(NCH - 1) * SC_CH + st) * DM + h * 64 + half * 32 + rr) = pack2(yv.x, yv.y);
      }
    } else {
      const int sub = lane & 15, rp = lane >> 4;
      const int rl = wave * 8 + rp * 2;
      v2f st[4];
#pragma unroll
      for (int e = 0; e < 4; e++) st[e] = (v2f){0.f, 0.f};
      for (int c = -1; c < NCH; c++) {
        if (c >= 0) {
          const float* cb = inbuf + ((c & 1) * SC_CH) * SC_STEP;
          float ys0 = 0.f, ys1 = 0.f;
          float4 cw4, cb4, ck4, ca4, cq4, cbv;
          float4 nw4, nb4, nk4, na4, nq4, nbv;
          {
            const float* base = cb;
            cw4 = *(const float4*)(base + sub * 4);
            cb4 = *(const float4*)(base + 64 + sub * 4);
            ck4 = *(const float4*)(base + 128 + sub * 4);
            ca4 = *(const float4*)(base + 192 + sub * 4);
            cq4 = *(const float4*)(base + 256 + sub * 4);
            cbv = *(const float4*)(base + 320 + rl * 2);
          }
#pragma unroll
          for (int s = 0; s < SC_CH; s++) {
            if (s + 1 < SC_CH) {
              const float* base = cb + (s + 1) * SC_STEP;
              nw4 = *(const float4*)(base + sub * 4);
              nb4 = *(const float4*)(base + 64 + sub * 4);
              nk4 = *(const float4*)(base + 128 + sub * 4);
              na4 = *(const float4*)(base + 192 + sub * 4);
              nq4 = *(const float4*)(base + 256 + sub * 4);
              nbv = *(const float4*)(base + 320 + rl * 2);
            }
            __builtin_amdgcn_sched_barrier(0);
            const v2f w01 = (v2f){cw4.x, cw4.y}, w23 = (v2f){cw4.z, cw4.w};
            const v2f b01 = (v2f){cb4.x, cb4.y}, b23 = (v2f){cb4.z, cb4.w};
            const v2f k01 = (v2f){ck4.x, ck4.y}, k23 = (v2f){ck4.z, ck4.w};
            const v2f a01 = (v2f){ca4.x, ca4.y}, a23 = (v2f){ca4.z, ca4.w};
            const v2f q01 = (v2f){cq4.x, cq4.y}, q23 = (v2f){cq4.z, cq4.w};
            v2f accA, accY;
            asm("v_pk_mul_f32 %0, %2, %6 op_sel_hi:[1,0]\n\t"
                "v_pk_mul_f32 %1, %2, %8 op_sel_hi:[1,0]\n\t"
                "v_pk_fma_f32 %0, %3, %6, %0 op_sel:[0,1,0]\n\t"
                "v_pk_fma_f32 %1, %3, %8, %1 op_sel:[0,1,0]\n\t"
                "v_pk_fma_f32 %0, %4, %7, %0 op_sel_hi:[1,0,1]\n\t"
                "v_pk_fma_f32 %1, %4, %9, %1 op_sel_hi:[1,0,1]\n\t"
                "v_pk_fma_f32 %0, %5, %7, %0 op_sel:[0,1,0]\n\t"
                "v_pk_fma_f32 %1, %5, %9, %1 op_sel:[0,1,0]"
                : "=&v"(accA), "=&v"(accY)
                : "v"(st[0]), "v"(st[1]), "v"(st[2]), "v"(st[3]), "v"(a01), "v"(a23), "v"(q01), "v"(q23));
            float sa0 = accA.x, sa1 = accA.y, sy0 = accY.x, sy1 = accY.y;
            row16_sum4(sa0, sa1, sy0, sy1);
            const v2f sa = (v2f){sa0, sa1};
            const v2f vv = (v2f){cbv.z, cbv.w};
            const v2f brkr = (v2f){cbv.x, cbv.y};
            const v2f sy2 = (v2f){sy0, sy1};
            v2f yy;
            asm("v_pk_fma_f32 %4, %5, %7, %8 op_sel_hi:[1,0,1]\n\t"
                "v_pk_mul_f32 %0, %0, %9 op_sel_hi:[1,0]\n\t"
                "v_pk_mul_f32 %1, %1, %9 op_sel:[0,1]\n\t"
                "v_pk_mul_f32 %2, %2, %10 op_sel_hi:[1,0]\n\t"
                "v_pk_mul_f32 %3, %3, %10 op_sel:[0,1]\n\t"
                "v_pk_fma_f32 %4, %6, %7, %4 op_sel:[0,1,0]\n\t"
                "v_pk_fma_f32 %0, %5, %11, %0 op_sel_hi:[1,0,1]\n\t"
                "v_pk_fma_f32 %1, %5, %11, %1 op_sel:[0,1,0]\n\t"
                "v_pk_fma_f32 %2, %5, %12, %2 op_sel_hi:[1,0,1]\n\t"
                "v_pk_fma_f32 %3, %5, %12, %3 op_sel:[0,1,0]\n\t"
                "v_pk_fma_f32 %0, %6, %13, %0 op_sel_hi:[1,0,1]\n\t"
                "v_pk_fma_f32 %1, %6, %13, %1 op_sel:[0,1,0]\n\t"
                "v_pk_fma_f32 %2, %6, %14, %2 op_sel_hi:[1,0,1]\n\t"
                "v_pk_fma_f32 %3, %6, %14, %3 op_sel:[0,1,0]"
                : "+v"(st[0]), "+v"(st[1]), "+v"(st[2]), "+v"(st[3]), "=&v"(yy)
                : "v"(sa), "v"(vv), "v"(brkr), "v"(sy2), "v"(w01), "v"(w23), "v"(b01), "v"(b23), "v"(k01), "v"(k23));
            const float y0 = yy.x, y1 = yy.y;
            ys0 = (s == sub) ? y0 : ys0;
            ys1 = (s == sub) ? y1 : ys1;
            cw4 = nw4; cb4 = nb4; ck4 = nk4; ca4 = na4; cq4 = nq4; cbv = nbv;
          }
          *(float2*)(ybuf + ((c & 1) * SC_CH + sub) * 32 + rl) = make_float2(ys0, ys1);
        }
        __syncthreads();
      }
    }
    __syncthreads();
  }
}

__device__ __forceinline__ void phase_norm2(const Params& p) {
  const int tid_ = opaque_tid(); const int lane = tid_ & 63, wave = tid_ >> 6;
  unsigned char* ws = p.ws;
  const float* X1 = (const float*)(ws + 2 * SLOT);
  const float* kvg = p.in[19];
  const float* bg = p.in[24];
  const float* modB = (const float*)(ws + OFF_MODB);
  bf16_t* A1 = (bf16_t*)(ws + 4 * SLOT);
  bf16_t* A2 = (bf16_t*)(ws + 5 * SLOT);
  for (int u = blockIdx.x; u < T_TOK / 8; u += gridDim.x) {
    const int t = u * 8 + wave;
    const int b = t >> 11;
    const float4* xr = (const float4*)(X1 + (size_t)t * DM);
    float4 cur[4];
    float ss = 0.f;
#pragma unroll
    for (int i = 0; i < 4; i++) {
      cur[i] = xr[(i >> 1) * 128 + lane * 2 + (i & 1)];
      ss += cur[i].x * cur[i].x + cur[i].y * cur[i].y + cur[i].z * cur[i].z + cur[i].w * cur[i].w;
    }
    ss = wave_sum(ss);
    const float rinv = __builtin_amdgcn_rsqf(ss * (1.0f / 1024.0f) + 1e-6f);
#pragma unroll
    for (int jp = 0; jp < 2; jp++) {
      const int d = jp * 512 + lane * 8;
      unsigned o1[4], o2[4];
#pragma unroll
      for (int hf = 0; hf < 2; hf++) {
        const int i = jp * 2 + hf;
        const float4 g1 = *(const float4*)(kvg + d + hf * 4);
        const float4 g2 = *(const float4*)(bg + d + hf * 4);
        const float4 sh = *(const float4*)(modB + b * 3072 + d + hf * 4);
        const float4 sc = *(const float4*)(modB + b * 3072 + 1024 + d + hf * 4);
        const float n0 = cur[i].x * rinv, n1 = cur[i].y * rinv, n2 = cur[i].z * rinv, n3 = cur[i].w * rinv;
        o1[hf * 2] = pack2(n0 * g1.x, n1 * g1.y); o1[hf * 2 + 1] = pack2(n2 * g1.z, n3 * g1.w);
        o2[hf * 2] = pack2(n0 * g2.x * (1.f + sc.x) + sh.x, n1 * g2.y * (1.f + sc.y) + sh.y);
        o2[hf * 2 + 1] = pack2(n2 * g2.z * (1.f + sc.z) + sh.z, n3 * g2.w * (1.f + sc.w) + sh.w);
      }
      const size_t o = (size_t)t * DM + d;
      *(uint4*)(A1 + o) = make_uint4(o1[0], o1[1], o1[2], o1[3]);
      *(uint4*)(A2 + o) = make_uint4(o2[0], o2[1], o2[2], o2[3]);
    }
  }
}

typedef __attribute__((ext_vector_type(4))) short s16x4;
typedef __attribute__((address_space(3))) s16x4 lds_s16x4;
__device__ __forceinline__ void phase_attn(const Params& p, unsigned char* lds) {
  bf16_t* Ks = (bf16_t*)lds;
  bf16_t* Vs = (bf16_t*)(lds + 256 * 144);
  const int tid = opaque_tid(), lane = tid & 63, wave = tid >> 6;
  const int c16 = lane & 15, quad = lane >> 4;
  unsigned char* ws = p.ws;
  const bf16_t* KSH = (const bf16_t*)(ws + 6 * SLOT);
  const bf16_t* VSH = (const bf16_t*)(ws + 7 * SLOT);
  bf16_t* Q0 = (bf16_t*)p.out;
  bf16_t* Q1 = (bf16_t*)((unsigned char*)p.out + SLOT);
  bf16_t* Q2 = (bf16_t*)(ws + 1 * SLOT);
  float2* ML = (float2*)(ws + OFF_SPARE);
  uint4 kreg[4], vreg[4];
  bf16x8 qreg0, qreg1;
  auto issue = [&](int tile) {
    const int g = tile >> 11, rem = tile & 2047;
    const int b = rem >> 8, h = (rem >> 4) & 15, jj = rem & 15;
    const int dsh = g * 2, dil = 1 << dsh;
    const int r = jj & (dil - 1), n = jj >> dsh;
    const size_t tokb = (size_t)b * SEQ;
    {
      const bf16_t* Qn = (g == 0) ? Q0 : (g == 1) ? Q1 : Q2;
      const size_t qo = (tokb + (size_t)((n * 128 + wave * 16 + c16) * dil + r)) * DM + h * 64;
      qreg0 = *(const bf16x8*)(Qn + qo + quad * 8);
      qreg1 = *(const bf16x8*)(Qn + qo + 32 + quad * 8);
    }
#pragma unroll
    for (int i = 0; i < 4; i++) {
      const int c = tid + i * 512;
      const int kl = c >> 3, ec = (c & 7) * 8;
      const int lp = (n - 1) * 128 + kl;
      kreg[i] = make_uint4(0, 0, 0, 0);
      vreg[i] = make_uint4(0, 0, 0, 0);
      if (lp >= 0) {
        const size_t off = (tokb + (size_t)(lp * dil + r)) * DM + h * 64 + ec;
        kreg[i] = *(const uint4*)(KSH + off);
        vreg[i] = *(const uint4*)(VSH + off);
      }
    }
  };
  int tile = blockIdx.x;
  if (tile < 6144) issue(tile);
  for (; tile < 6144; tile += gridDim.x) {
    const int g = tile >> 11, rem = tile & 2047;
    const int b = rem >> 8, h = (rem >> 4) & 15, jj = rem & 15;
    const int dsh = g * 2, dil = 1 << dsh;
    const int r = jj & (dil - 1), n = jj >> dsh;
    bf16_t* Qg = (g == 0) ? Q0 : (g == 1) ? Q1 : Q2;
    const size_t tokb = (size_t)b * SEQ;
#pragma unroll
    for (int i = 0; i < 4; i++) {
      const int c = tid + i * 512;
      const int kl = c >> 3, ec = (c & 7) * 8;
      *(uint4*)(Ks + kl * 72 + ec) = kreg[i];
      *(uint4*)(Vs + kl * 72 + ec) = vreg[i];
    }
    const bf16x8 qf0 = qreg0, qf1 = qreg1;
    __syncthreads();
    if (tile + (int)gridDim.x < 6144) issue(tile + gridDim.x);
    __builtin_amdgcn_sched_barrier(0);
    const int lq = n * 128 + wave * 16 + c16;
    const int posq = lq * dil + r;
    const size_t qoff = (tokb + posq) * DM + h * 64;
    f32x4 sc[9];
#pragma unroll
    for (int t = 0; t < 9; t++) {
      const bf16_t* krow = Ks + ((wave + t) * 16 + c16) * 72 + quad * 8;
      const bf16x8 a0 = *(const bf16x8*)krow;
      const bf16x8 a1 = *(const bf16x8*)(krow + 32);
      f32x4 sv = (f32x4){0.f, 0.f, 0.f, 0.f};
      sv = __builtin_amdgcn_mfma_f32_16x16x32_bf16(a0, qf0, sv, 0, 0, 0);
      sv = __builtin_amdgcn_mfma_f32_16x16x32_bf16(a1, qf1, sv, 0, 0, 0);
      sc[t] = sv;
    }
    __builtin_amdgcn_sched_barrier(0);
    float m = -1e30f;
    const int dm = c16 - quad * 4;
#pragma unroll
    for (int t = 0; t < 9; t++) {
      const bool tile_ok = (n > 0) || (wave + t >= 8);
#pragma unroll
      for (int j = 0; j < 4; j++) {
        bool valid = tile_ok;
        if (t == 0) valid = valid && (dm <= j);
        if (t == 8) valid = valid && (dm >= j);
        const float v = valid ? sc[t][j] : -1e30f;
        sc[t][j] = v;
        m = fmaxf(m, v);
      }
    }
    m = fmaxf(m, __shfl_xor(m, 16));
    m = fmaxf(m, __shfl_xor(m, 32));
    float l = 0.f;
#pragma unroll
    for (int t = 0; t < 9; t++)
#pragma unroll
      for (int j = 0; j < 4; j++) {
        const float pv = __builtin_amdgcn_exp2f(sc[t][j] - m);
        sc[t][j] = pv;
        l += pv;
      }
    l += __shfl_xor(l, 16);
    l += __shfl_xor(l, 32);
    __builtin_amdgcn_sched_barrier(0);
    f32x4 o[4];
#pragma unroll
    for (int ct = 0; ct < 4; ct++) o[ct] = (f32x4){0.f, 0.f, 0.f, 0.f};
    const int tq = c16 >> 2, tp = c16 & 3;
#pragma unroll
    for (int pr = 0; pr < 5; pr++) {
      const int ta = 2 * pr;
      const int tb = (pr < 4) ? (2 * pr + 1) : ta;
      union { bf16x8 v; unsigned u[4]; } pf;
      pf.u[0] = pack2(sc[ta][0], sc[ta][1]);
      pf.u[1] = pack2(sc[ta][2], sc[ta][3]);
      if (pr < 4) {
        pf.u[2] = pack2(sc[tb][0], sc[tb][1]);
        pf.u[3] = pack2(sc[tb][2], sc[tb][3]);
      } else {
        pf.u[2] = 0; pf.u[3] = 0;
      }
      __builtin_amdgcn_sched_barrier(0);
      const bf16_t* va = Vs + ((wave + ta) * 16 + quad * 4 + tq) * 72 + 8 * tp;
      const bf16_t* vb = Vs + ((wave + tb) * 16 + quad * 4 + tq) * 72 + 8 * tp;
#pragma unroll
      for (int ct = 0; ct < 4; ct++) {
        union { bf16x8 v; s16x4 h[2]; } vf;
        vf.h[0] = __builtin_amdgcn_ds_read_tr16_b64_v4i16((lds_s16x4*)(va + (ct >> 1) * 32 + (ct & 1) * 4));
        vf.h[1] = __builtin_amdgcn_ds_read_tr16_b64_v4i16((lds_s16x4*)(vb + (ct >> 1) * 32 + (ct & 1) * 4));
        o[ct] = __builtin_amdgcn_mfma_f32_16x16x32_bf16(vf.v, pf.v, o[ct], 0, 0, 0);
      }
    }
    __builtin_amdgcn_sched_barrier(0);
    const float inv = __builtin_amdgcn_rcpf(l);
#pragma unroll
    for (int pp = 0; pp < 2; pp++) {
      const uint2 lo = pack4(o[2 * pp][0] * inv, o[2 * pp][1] * inv, o[2 * pp][2] * inv, o[2 * pp][3] * inv);
      const uint2 hi = pack4(o[2 * pp + 1][0] * inv, o[2 * pp + 1][1] * inv, o[2 * pp + 1][2] * inv, o[2 * pp + 1][3] * inv);
      *(uint4*)(Qg + qoff + pp * 32 + quad * 8) = make_uint4(lo.x, lo.y, hi.x, hi.y);
    }
    if (quad == 0) ML[((size_t)g * T_TOK + tokb + posq) * 16 + h] = make_float2(m, l);
    __syncthreads();
  }
}

template <int ph>
__device__ __forceinline__ void run_phase(const Params& p, unsigned char* lds) {
  unsigned char* ws = p.ws;
  unsigned char* dob = (unsigned char*)p.out;
  const float* cs = (const float*)(ws + OFF_ROPE);
  const float* sn = cs + 65536;
  switch (ph) {
    case 0: phase_prep(p, lds, 0, 192); break;
    case 1: phase_mix(p); phase_prep(p, lds, 192, 512 + 3168); break;
    case 2: {
      const bf16_t* XS[4] = {(const bf16_t*)dob, (const bf16_t*)(dob + SLOT), (const bf16_t*)(ws + 2 * SLOT), (const bf16_t*)(ws + 7 * SLOT)};
      unsigned* flags = (unsigned*)(ws + OFF_PANEL);
      const bf16_t* LO1 = (const bf16_t*)(ws + OFF_SPARE);
      const bool merged = (gridDim.x == 256);
      auto big_tile = [&](int idx) __attribute__((always_inline)) {
        const int li = idx >> 3;
        const int m = (idx & 7) * 8 + (li & 7), n = li >> 3;
        const int pp = n >> 2;
        const bf16_t* A = (pp == 0) ? XS[0] : (pp == 1) ? XS[1] : XS[2];
        GemmArgs g{A, A, 1024, 1024, (const bf16_t*)(ws + OFF_WT_AIN), 1024, 1024};
        EpiStoreBf16 e{(bf16_t*)(ws + 4 * SLOT), 3072, 0};
        gemm_tile256(g, m * 256, n * 256, lds, e);
      };
      auto lora1_tile = [&](int m) __attribute__((always_inline)) {
        GemmArgs g{(const bf16_t*)dob, (const bf16_t*)(ws + 3 * SLOT), 1024, 1024, (const bf16_t*)(ws + OFF_WT_LORA1), 2048, 2048};
        EpiLora1 e{(bf16_t*)(ws + OFF_SPARE)};
        gemm_tile(g, m * 256, 0, lds, e);
      };
      auto lora2_tile = [&](int sidx) __attribute__((always_inline)) {
        const int m = sidx >> 4, n = sidx & 15;
        if (n < 8) {
          GemmArgs g{LO1, LO1, 64, 128, (const bf16_t*)(ws + OFF_WT_W2), 64, 64};
          EpiLora2W e{(bf16_t*)(ws + 3 * SLOT), p.in[7]};
          gemm_tile(g, m * 256, n * 128, lds, e);
        } else {
          GemmArgs g{LO1 + 64, LO1 + 64, 64, 128, (const bf16_t*)(ws + OFF_WT_A2), 64, 64};
          EpiLora2A e{(bf16_t*)(ws + 1 * SLOT), p.in[10]};
          gemm_tile(g, m * 256, (n - 8) * 128, lds, e);
        }
      };
      if (merged) {
        const int v = blockIdx.x;
        if (v < 64) {
          lora1_tile(v);
          asm volatile("s_waitcnt vmcnt(0)" ::: "memory");
          __syncthreads();
          if (threadIdx.x == 0) {
            __builtin_amdgcn_fence(__ATOMIC_RELEASE, "agent");
            asm volatile("s_waitcnt vmcnt(0)" ::: "memory");
            __hip_atomic_store(flags + v, 1u, __ATOMIC_RELAXED, __HIP_MEMORY_SCOPE_AGENT);
          }
        }
        for (int k = 0; k < 3; k++) big_tile(v + 256 * k);
        const int ns = (v < 64) ? 1 : 5;
        const int s0 = (v < 64) ? v : 64 + (v - 64) * 5;
        int have = -1;
        for (int j = 0; j < ns; j++) {
          const int sidx = s0 + j, m = sidx >> 4;
          if (m != have) {
            if (threadIdx.x < 64) {
              unsigned spins = 0;
              while ((unsigned)__builtin_amdgcn_readfirstlane(__hip_atomic_load(flags + m, __ATOMIC_RELAXED, __HIP_MEMORY_SCOPE_AGENT)) != 1u) {
                __builtin_amdgcn_s_sleep(2);
                if (++spins > (1u << 22)) break;
              }
              __builtin_amdgcn_fence(__ATOMIC_ACQUIRE, "agent");
              asm volatile("s_waitcnt vmcnt(0)" ::: "memory");
            }
            __syncthreads();
            have = m;
          }
          lora2_tile(sidx);
        }
      } else {
        for (int idx = blockIdx.x; idx < 768 + 64; idx += gridDim.x) {
          if (idx < 768) big_tile(idx); else lora1_tile(idx - 768);
        }
      }
    } break;
    case 3: {
      if (gridDim.x != 256) {
        const bf16_t* LO1 = (const bf16_t*)(ws + OFF_SPARE);
        for (int idx = blockIdx.x; idx < 64 * 16; idx += gridDim.x) {
          const int m = idx >> 4, n = idx & 15;
          if (n < 8) {
            GemmArgs g{LO1, LO1, 64, 128, (const bf16_t*)(ws + OFF_WT_W2), 64, 64};
            EpiLora2W e{(bf16_t*)(ws + 3 * SLOT), p.in[7]};
            gemm_tile(g, m * 256, n * 128, lds, e);
          } else {
            GemmArgs g{LO1 + 64, LO1 + 64, 64, 128, (const bf16_t*)(ws + OFF_WT_A2), 64, 64};
            EpiLora2A e{(bf16_t*)(ws + 1 * SLOT), p.in[10]};
            gemm_tile(g, m * 256, (n - 8) * 128, lds, e);
          }
        }
      }
    } break;
    case 4: phase_scan(p, lds); break;
    case 5: {
      for (int idx = blockIdx.x; idx < 64 * 4; idx += gridDim.x) {
        const int m = (idx & 7) * 8 + (idx >> 5), n = (idx >> 3) & 3;
        const bf16_t* XS3 = (const bf16_t*)(ws + 7 * SLOT);
        GemmArgs g{XS3, XS3, 1024, 1024, (const bf16_t*)(ws + OFF_WT_AIN) + (size_t)3072 * 1024, 1024, 1024};
        EpiGPost e{(const bf16_t*)(ws + 2 * SLOT), (const bf16_t*)(ws + 4 * SLOT), (const float*)(ws + OFF_SPARE),
                   p.in[16], p.in[17], (bf16_t*)dob};
        gemm_tile256(g, m * 256, n * 256, lds, e);
      }
    } break;
    case 6: {
      for (int idx = blockIdx.x; idx < 64 * 4; idx += gridDim.x) {
        const int m = (idx & 7) * 8 + (idx >> 5), n = (idx >> 3) & 3;
        const bf16_t* A4 = (const bf16_t*)dob;
        GemmArgs g{A4, A4, 1024, 1024, (const bf16_t*)(ws + OFF_WT_AOUT), 1024, 1024};
        EpiResidual e{p.in[0], (const float*)(ws + OFF_MODA) + 2048, (float*)(ws + 2 * SLOT)};
        gemm_tile256(g, m * 256, n * 256, lds, e);
      }
    } break;
    case 7: phase_norm2(p); break;
    case 8: {
      for (int idx = blockIdx.x; idx < 64 * 20; idx += gridDim.x) {
        const int li = idx >> 3;
        const int m = (idx & 7) * 8 + (li & 7), n = li >> 3;
        if (n < 8) {
          const bf16_t* A1 = (const bf16_t*)(ws + 4 * SLOT);
          GemmArgs g{A1, A1, 1024, 1024, (const bf16_t*)(ws + OFF_WT_KV), 1024, 1024};
          EpiKV e{(bf16_t*)(ws + 6 * SLOT), (bf16_t*)(ws + 7 * SLOT), p.in[21], cs, sn};
          gemm_tile256(g, m * 256, n * 256, lds, e);
        } else {
          const bf16_t* A2 = (const bf16_t*)(ws + 5 * SLOT);
          GemmArgs g{A2, A2, 1024, 1024, (const bf16_t*)(ws + OFF_WT_BIN), 1024, 1024};
          EpiQ e{(bf16_t*)dob, (bf16_t*)(dob + SLOT), (bf16_t*)(ws + 1 * SLOT), p.in[26], cs, sn};
          gemm_tile256(g, m * 256, (n - 8) * 256, lds, e);
        }
      }
    } break;
    case 9: phase_attn(p, lds); break;
    case 10: {
      for (int idx = blockIdx.x; idx < 64 * 4; idx += gridDim.x) {
        const int m = (idx & 7) * 8 + (idx >> 5), n = (idx >> 3) & 3;
        const bf16_t* A2 = (const bf16_t*)(ws + 5 * SLOT);
        GemmArgs g{A2, A2, 1024, 1024, (const bf16_t*)(ws + OFF_WT_BIN) + (size_t)3072 * 1024, 1024, 1024};
        EpiMerge e{(const bf16_t*)dob, (const bf16_t*)(dob + SLOT), (const bf16_t*)(ws + 1 * SLOT), (const float2*)(ws + OFF_SPARE), (bf16_t*)(ws + 4 * SLOT)};
        gemm_tile256(g, m * 256, n * 256, lds, e);
      }
    } break;
    case 11: {
      for (int idx = blockIdx.x; idx < 64 * 4; idx += gridDim.x) {
        const int m = (idx & 7) * 8 + (idx >> 5), n = (idx >> 3) & 3;
        const bf16_t* A7 = (const bf16_t*)(ws + 4 * SLOT);
        GemmArgs g{A7, A7, 1024, 1024, (const bf16_t*)(ws + OFF_WT_BOUT), 1024, 1024};
        EpiResidual e{(const float*)(ws + 2 * SLOT), (const float*)(ws + OFF_MODB) + 2048, p.out};
        gemm_tile256(g, m * 256, n * 256, lds, e);
      }
    } break;
    default: break;
  }
}

template <int PH>
__global__ void __launch_bounds__(NTHREADS) phase_kernel(Params p) {
  extern __shared__ __attribute__((aligned(16))) unsigned char lds[];
  run_phase<PH>(p, lds);
}

__global__ void __launch_bounds__(NTHREADS) mega_kernel(Params p) {
  extern __shared__ __attribute__((aligned(16))) unsigned char lds[];
  cg::grid_group grid = cg::this_grid();
  if (p.ws == nullptr) grid.sync();
  volatile LAS unsigned* xst = (volatile LAS unsigned*)(lds + LDS_BYTES - 16);
  if (threadIdx.x == 0) { xst[0] = 0u; xst[1] = 0u; xst[2] = 0u; xst[3] = 0u; }
  __syncthreads();
  const XcdBarrier xb = xcd_barrier_post((unsigned*)(p.ws + OFF_BAR), xst);
  run_phase<0>(p, lds); xcd_barrier(xb);
  if (PROBE_DOUBLE == 0) { run_phase<0>(p, lds); xcd_barrier(xb); }
  run_phase<1>(p, lds); xcd_barrier(xb);
  if (PROBE_DOUBLE == 1) { run_phase<1>(p, lds); xcd_barrier(xb); }
  run_phase<2>(p, lds);
  if (gridDim.x != 256) xcd_barrier(xb);
  if (PROBE_DOUBLE == 2) { run_phase<2>(p, lds); xcd_barrier(xb); }
  run_phase<3>(p, lds); xcd_barrier(xb);
  if (PROBE_DOUBLE == 3) { run_phase<3>(p, lds); xcd_barrier(xb); }
  run_phase<4>(p, lds); xcd_barrier(xb);
  if (PROBE_DOUBLE == 4) { run_phase<4>(p, lds); xcd_barrier(xb); }
  run_phase<5>(p, lds); xcd_barrier(xb);
  if (PROBE_DOUBLE == 5) { run_phase<5>(p, lds); xcd_barrier(xb); }
  run_phase<6>(p, lds); xcd_barrier(xb);
  if (PROBE_DOUBLE == 6) { run_phase<6>(p, lds); xcd_barrier(xb); }
  run_phase<7>(p, lds); xcd_barrier(xb);
  if (PROBE_DOUBLE == 7) { run_phase<7>(p, lds); xcd_barrier(xb); }
  run_phase<8>(p, lds); xcd_barrier(xb);
  if (PROBE_DOUBLE == 8) { run_phase<8>(p, lds); xcd_barrier(xb); }
  run_phase<9>(p, lds); xcd_barrier(xb);
  if (PROBE_DOUBLE == 89) { run_phase<8>(p, lds); xcd_barrier(xb); run_phase<9>(p, lds); xcd_barrier(xb); }
  run_phase<10>(p, lds); xcd_barrier(xb);
  if (PROBE_DOUBLE == 10) { run_phase<10>(p, lds); xcd_barrier(xb); }
  run_phase<11>(p, lds);
}

template <int PH>
static void launch_phase(const Params& p, int grid, hipStream_t stream) {
  static bool attr = false;
  if (!attr) { (void)hipFuncSetAttribute((const void*)phase_kernel<PH>, hipFuncAttributeMaxDynamicSharedMemorySize, LDS_BYTES); attr = true; }
  hipLaunchKernelGGL(phase_kernel<PH>, dim3(grid), dim3(NTHREADS), LDS_BYTES, stream, p);
}

extern "C" void kernel_launch(void* const* d_in, const int* in_sizes, int n_in, void* d_out, int out_size, void* d_ws,
                              size_t ws_size, hipStream_t stream) {
  static int grid = 0;
  if (grid == 0) {
    int dev = 0, cus = 0;
    if (n_in != 28 || out_size != T_TOK * DM || ws_size < 256 * MiB) {
      fprintf(stderr, "kernel_launch: unexpected shapes n_in=%d out=%d ws=%zu\n", n_in, out_size, ws_size);
      grid = -1;
      return;
    }
    (void)hipGetDevice(&dev);
    (void)hipDeviceGetAttribute(&cus, hipDeviceAttributeMultiprocessorCount, dev);
    (void)hipFuncSetAttribute((const void*)mega_kernel, hipFuncAttributeMaxDynamicSharedMemorySize, LDS_BYTES);
    int per_cu = 0;
    (void)hipOccupancyMaxActiveBlocksPerMultiprocessor(&per_cu, (const void*)mega_kernel, NTHREADS, LDS_BYTES);
    if (per_cu < 1) fprintf(stderr, "kernel_launch: occupancy query says %d blocks/CU\n", per_cu);
    (void)hipGetLastError();
    grid = cus > 0 ? cus : 256;
  }
  if (grid < 0) return;
  Params p{};
  for (int i = 0; i < 28; i++) p.in[i] = (const float*)d_in[i];
  p.out = (float*)d_out;
  p.ws = (unsigned char*)d_ws;
#if ONE_LAUNCH
  (void)hipMemsetAsync((unsigned char*)d_ws + OFF_BAR, 0, 16384, stream);
  void* args[] = {&p};
  hipError_t e = hipLaunchCooperativeKernel((const void*)mega_kernel, dim3(grid), dim3(NTHREADS), args, LDS_BYTES, stream);
  if (e != hipSuccess) fprintf(stderr, "cooperative launch failed: %s (grid %d)\n", hipGetErrorString(e), grid);
#else
  launch_phase<0>(p, grid, stream); launch_phase<1>(p, grid, stream); launch_phase<2>(p, grid, stream);
  launch_phase<3>(p, grid, stream); launch_phase<4>(p, grid, stream); launch_phase<5>(p, grid, stream);
  launch_phase<6>(p, grid, stream); launch_phase<7>(p, grid, stream); launch_phase<8>(p, grid, stream);
  launch_phase<9>(p, grid, stream); launch_phase<10>(p, grid, stream); launch_phase<11>(p, grid, stream);
#endif
}
```
